# Optimizing an MI355X kernel written in HIP

```python
import math
import jax, jax.numpy as jnp
from jax import lax
import numpy as np

D_MODEL = 2048
BATCH = 8
SEQ = 2048
DEPTH = 2

PLE_DIM = 256
HEAD_DIM = 128
POOL_WIDTH = D_MODEL // 4
POOL_WINDOWS = (2, 4, 8, 16)
POOL_GROUP = POOL_WIDTH // len(POOL_WINDOWS)
FOX_HEADS = (D_MODEL - POOL_WIDTH) // (2 * HEAD_DIM)
FOX_WIDTH = FOX_HEADS * HEAD_DIM
MOBA_HEADS = FOX_HEADS
MOBA_WIDTH = MOBA_HEADS * HEAD_DIM
MOBA_BLOCK = 256
MOBA_TOPK = 3
MOBA_QCHUNK = 16
FOX_QBLOCK = 128
REL_BUCKETS = 32
REL_MAX_EXACT = REL_BUCKETS // 2
REL_MAX_DIST = 128
D_FF = 5632
IN_WIDTH = POOL_WIDTH + 3 * FOX_WIDTH + FOX_HEADS + 3 * MOBA_WIDTH
EPS = 1e-6

kernel_name = "hybrid_pool_fox_moba_macaron"


def rms_norm(x, g):
    xf = x.astype(jnp.float32)
    y = xf * lax.rsqrt(jnp.mean(xf * xf, axis=-1, keepdims=True) + EPS)
    return (y * g.astype(jnp.float32)).astype(x.dtype)


def swiglu(x, w_gate, w_up, w_down):
    return (jax.nn.silu(x @ w_gate) * (x @ w_up)) @ w_down


def t5_bucket(dist):
    n = jnp.maximum(dist, 0)
    nf = jnp.maximum(n, 1).astype(jnp.float32)
    large = REL_MAX_EXACT + (jnp.log(nf / REL_MAX_EXACT) / math.log(REL_MAX_DIST / REL_MAX_EXACT)
                             * (REL_BUCKETS - REL_MAX_EXACT)).astype(jnp.int32)
    large = jnp.minimum(large, REL_BUCKETS - 1)
    return jnp.where(n < REL_MAX_EXACT, n, large)


def pool_mixer(v, pool_w, pool_scale):
    B, S, _ = v.shape
    vf = v.astype(jnp.float32)
    cs = jnp.cumsum(vf, axis=1)
    tpos = jnp.arange(S, dtype=jnp.float32)
    outs = []
    for g, w in enumerate(POOL_WINDOWS):
        lo, hi = g * POOL_GROUP, (g + 1) * POOL_GROUP
        csg = cs[..., lo:hi]
        prev = jnp.pad(csg, ((0, 0), (w, 0), (0, 0)))[:, :S]
        cnt = jnp.minimum(tpos + 1.0, float(w))[None, :, None]
        d = ((csg - prev) / cnt - vf[..., lo:hi]).astype(v.dtype)
        outs.append(d @ pool_w[g])
    return jnp.concatenate(outs, axis=-1) * pool_scale


def fox_attention(q, k, v, log_f):
    B, S, H, D = q.shape
    scale = D ** -0.5
    c = jnp.cumsum(log_f, axis=1).transpose(0, 2, 1)
    outs = []
    for i in range(S // FOX_QBLOCK):
        s0, s1 = i * FOX_QBLOCK, (i + 1) * FOX_QBLOCK
        sc = jnp.einsum('bqhd,bkhd->bhqk', q[:, s0:s1], k[:, :s1]).astype(jnp.float32) * scale
        sc = sc + c[:, :, s0:s1, None] - c[:, :, None, :s1]
        mask = jnp.arange(s0, s1)[:, None] >= jnp.arange(s1)[None, :]
        sc = jnp.where(mask, sc, -jnp.inf)
        pr = jax.nn.softmax(sc, axis=-1).astype(v.dtype)
        outs.append(jnp.einsum('bhqk,bkhd->bqhd', pr, v[:, :s1]))
    return jnp.concatenate(outs, axis=1)


def moba_attention(q, k, v, rel_bias):
    B, S, H, D = q.shape
    nb = -(-S // MOBA_BLOCK)
    s_pad = nb * MOBA_BLOCK
    pad = ((0, 0), (0, s_pad - S), (0, 0), (0, 0))
    k_pad = jnp.pad(k, pad)
    v_pad = jnp.pad(v, pad)
    k_blk = k_pad.reshape(B, nb, MOBA_BLOCK, H, D)
    k_mean = jnp.mean(k_blk.astype(jnp.float32), axis=2)
    kb = k_blk.transpose(0, 3, 1, 2, 4)
    vb = v_pad.reshape(B, nb, MOBA_BLOCK, H, D).transpose(0, 3, 1, 2, 4)
    k_sel = min(MOBA_TOPK, nb)
    scale = D ** -0.5
    b_idx = jnp.arange(B)[:, None, None, None]
    h_idx = jnp.arange(H)[None, None, :, None]
    blk_ar = jnp.arange(nb)
    in_blk = jnp.arange(MOBA_BLOCK)
    QC = MOBA_QCHUNK

    def chunk(ci):
        t0 = ci * QC
        own = t0 // MOBA_BLOCK
        qc = lax.dynamic_slice_in_dim(q, t0, QC, axis=1)
        tpos = t0 + jnp.arange(QC)
        gate = jnp.einsum('bqhd,bnhd->bqhn', qc.astype(jnp.float32), k_mean)
        gate = jnp.where(blk_ar < own, gate, -jnp.inf)
        _, idx = lax.top_k(gate, k_sel)
        valid = idx < own
        kg = kb[b_idx, h_idx, idx]
        vg = vb[b_idx, h_idx, idx]
        s_sel = jnp.einsum('bqhd,bqhnkd->bqhnk', qc, kg).astype(jnp.float32) * scale
        kpos = idx[..., None] * MOBA_BLOCK + in_blk
        dist = tpos[None, :, None, None, None] - kpos
        s_sel = s_sel + rel_bias[t5_bucket(dist), h_idx[..., None]].astype(jnp.float32)
        s_sel = jnp.where(valid[..., None], s_sel, -jnp.inf)
        k_own = lax.dynamic_slice_in_dim(k_pad, own * MOBA_BLOCK, MOBA_BLOCK, axis=1)
        v_own = lax.dynamic_slice_in_dim(v_pad, own * MOBA_BLOCK, MOBA_BLOCK, axis=1)
        s_own = jnp.einsum('bqhd,bkhd->bqhk', qc, k_own).astype(jnp.float32) * scale
        dist_own = tpos[:, None] - (own * MOBA_BLOCK + in_blk)[None, :]
        bias_own = rel_bias[t5_bucket(dist_own)].astype(jnp.float32).transpose(0, 2, 1)
        s_own = jnp.where((dist_own >= 0)[:, None, :], s_own + bias_own, -jnp.inf)
        scores = jnp.concatenate([s_sel.reshape(B, QC, H, k_sel * MOBA_BLOCK), s_own], axis=-1)
        pr = jax.nn.softmax(scores, axis=-1).astype(v.dtype)
        p_sel = pr[..., :k_sel * MOBA_BLOCK].reshape(B, QC, H, k_sel, MOBA_BLOCK)
        p_own = pr[..., k_sel * MOBA_BLOCK:]
        return (jnp.einsum('bqhnk,bqhnkd->bqhd', p_sel, vg)
                + jnp.einsum('bqhk,bkhd->bqhd', p_own, v_own))

    out = lax.map(chunk, jnp.arange(S // QC))
    return out.transpose(1, 0, 2, 3, 4).reshape(B, S, H, D)


def setup_inputs(seed: int = 0) -> dict:
    key = jax.random.key(seed)
    ks = jax.random.split(key, 32)
    f32 = jnp.float32

    def nrm(k, shape, fan_in):
        return jax.random.normal(k, shape, f32) * (fan_in ** -0.5)

    def gain(k, shape):
        return 1.0 + 0.05 * jax.random.normal(k, shape, f32)

    return {
        "x": jax.random.normal(ks[0], (BATCH, SEQ, D_MODEL), f32),
        "p": jax.random.normal(ks[1], (DEPTH, BATCH, SEQ, PLE_DIM), f32),
        "rel_bias": 0.5 * jax.random.normal(ks[2], (REL_BUCKETS, MOBA_HEADS), f32),
        "ffn1_pre_g": gain(ks[3], (DEPTH, D_MODEL)),
        "ffn1_post_g": gain(ks[4], (DEPTH, D_MODEL)),
        "ffn1_w_gate": nrm(ks[5], (DEPTH, D_MODEL, D_FF), D_MODEL),
        "ffn1_w_up": nrm(ks[6], (DEPTH, D_MODEL, D_FF), D_MODEL),
        "ffn1_w_down": nrm(ks[7], (DEPTH, D_FF, D_MODEL), D_FF),
        "mix_pre_g": gain(ks[8], (DEPTH, D_MODEL)),
        "mix_post_g": gain(ks[9], (DEPTH, D_MODEL)),
        "w_in": nrm(ks[10], (DEPTH, D_MODEL, IN_WIDTH), D_MODEL),
        "fox_forget_bias": jax.random.uniform(ks[11], (DEPTH, FOX_HEADS), f32, 1.0, 4.0),
        "pool_w": nrm(ks[12], (DEPTH, len(POOL_WINDOWS), POOL_GROUP, POOL_GROUP), POOL_GROUP),
        "pool_scale": gain(ks[13], (DEPTH, POOL_WIDTH)),
        "w_out": nrm(ks[14], (DEPTH, D_MODEL, D_MODEL), D_MODEL),
        "ffn2_pre_g": gain(ks[15], (DEPTH, D_MODEL)),
        "ffn2_post_g": gain(ks[16], (DEPTH, D_MODEL)),
        "ffn2_w_gate": nrm(ks[17], (DEPTH, D_MODEL, D_FF), D_MODEL),
        "ffn2_w_up": nrm(ks[18], (DEPTH, D_MODEL, D_FF), D_MODEL),
        "ffn2_w_down": nrm(ks[19], (DEPTH, D_FF, D_MODEL), D_FF),
        "ple_pre_g": gain(ks[20], (DEPTH, D_MODEL)),
        "ple_post_g": gain(ks[21], (DEPTH, D_MODEL)),
        "ple_w_gate": nrm(ks[22], (DEPTH, D_MODEL, D_MODEL), D_MODEL),
        "ple_w_proj": nrm(ks[23], (DEPTH, PLE_DIM, D_MODEL), PLE_DIM),
    }


def reference(x, p, rel_bias, ffn1_pre_g, ffn1_post_g, ffn1_w_gate, ffn1_w_up, ffn1_w_down,
              mix_pre_g, mix_post_g, w_in, fox_forget_bias, pool_w, pool_scale, w_out,
              ffn2_pre_g, ffn2_post_g, ffn2_w_gate, ffn2_w_up, ffn2_w_down,
              ple_pre_g, ple_post_g, ple_w_gate, ple_w_proj):
    B, S, _ = x.shape
    o_fq = POOL_WIDTH
    o_fk = o_fq + FOX_WIDTH
    o_fv = o_fk + FOX_WIDTH
    o_ff = o_fv + FOX_WIDTH
    o_mq = o_ff + FOX_HEADS
    o_mk = o_mq + MOBA_WIDTH
    o_mv = o_mk + MOBA_WIDTH
    h = x
    for i in range(DEPTH):
        f = swiglu(rms_norm(h, ffn1_pre_g[i]), ffn1_w_gate[i], ffn1_w_up[i], ffn1_w_down[i])
        h = h + 0.5 * rms_norm(f, ffn1_post_g[i])
        u = rms_norm(h, mix_pre_g[i])
        z = u @ w_in[i]
        y_pool = pool_mixer(z[..., :o_fq], pool_w[i], pool_scale[i])
        fq = z[..., o_fq:o_fk].reshape(B, S, FOX_HEADS, HEAD_DIM)
        fk = z[..., o_fk:o_fv].reshape(B, S, FOX_HEADS, HEAD_DIM)
        fv = z[..., o_fv:o_ff].reshape(B, S, FOX_HEADS, HEAD_DIM)
        log_f = jax.nn.log_sigmoid(z[..., o_ff:o_mq].astype(jnp.float32)
                                   + fox_forget_bias[i].astype(jnp.float32))
        y_fox = fox_attention(fq, fk, fv, log_f).reshape(B, S, FOX_WIDTH)
        mq = z[..., o_mq:o_mk].reshape(B, S, MOBA_HEADS, HEAD_DIM)
        mk = z[..., o_mk:o_mv].reshape(B, S, MOBA_HEADS, HEAD_DIM)
        mv = z[..., o_mv:].reshape(B, S, MOBA_HEADS, HEAD_DIM)
        y_moba = moba_attention(mq, mk, mv, rel_bias).reshape(B, S, MOBA_WIDTH)
        y = jnp.concatenate([y_pool, y_fox, y_moba], axis=-1) @ w_out[i]
        h = h + rms_norm(y, mix_post_g[i])
        f = swiglu(rms_norm(h, ffn2_pre_g[i]), ffn2_w_gate[i], ffn2_w_up[i], ffn2_w_down[i])
        h = h + 0.5 * rms_norm(f, ffn2_post_g[i])
        g = jax.nn.sigmoid(rms_norm(h, ple_pre_g[i]) @ ple_w_gate[i])
        e = p[i] @ ple_w_proj[i]
        h = h + rms_norm(g * e, ple_post_g[i])
    return h
```

```cpp
#include <hip/hip_runtime.h>
#include <hip/hip_cooperative_groups.h>
#include <cstdio>
#include <cstdint>
namespace cg = cooperative_groups;
__device__ __forceinline__ int tid_launder() { int t = threadIdx.x; asm volatile("" : "+v"(t)); return t; }
#define TIDX tid_launder()
#ifndef WT_STORES
#define WT_STORES 0
#endif
typedef unsigned wt_u32x4 __attribute__((ext_vector_type(4)));
typedef unsigned wt_u32x2 __attribute__((ext_vector_type(2)));
__device__ __forceinline__ void st16(void* p, wt_u32x4 v) {
#if WT_STORES
    asm volatile("global_store_dwordx4 %0, %1, off sc1\n\ts_nop 1" :: "v"(p), "v"(v) : "memory");
#else
    *(wt_u32x4*)p = v;
#endif
}
__device__ __forceinline__ void st8(void* p, wt_u32x2 v) {
#if WT_STORES
    asm volatile("global_store_dwordx2 %0, %1, off sc1\n\ts_nop 1" :: "v"(p), "v"(v) : "memory");
#else
    *(wt_u32x2*)p = v;
#endif
}
#ifndef N_LAUNCH_MODE
#define N_LAUNCH_MODE 1
#endif
namespace pg8 {
#define PG8_LAS __attribute__((address_space(3)))
typedef unsigned short bf16_t;
typedef short bf16x8 __attribute__((ext_vector_type(8)));
typedef float f32x4 __attribute__((ext_vector_type(4)));
typedef unsigned u32x4 __attribute__((ext_vector_type(4)));
constexpr int BM = 256, BK = 64, HALF = 128, HTB = HALF * BK * 2  , STAGE_BYTES = 8 * HTB, NXCD = 8, WGM = 8;

__host__ __device__ __forceinline__ int lds_byte(int r, int c) { const int st = (r >> 4) * 2 + (c >> 5), rr = r & 15, cc = c & 31, ob = rr * 64 + cc * 2; return st * 1024 + (ob ^ (((ob >> 9) & 1) << 5)); }
__host__ __device__ __forceinline__ void stage_rc(int b, int& R, int& C) { const int st = b / 1024, sb = b % 1024, swz = sb ^ (((sb >> 9) & 1) << 5); R = (st >> 1) * 16 + swz / 64; C = (st & 1) * 32 + (swz % 64) / 2; }
__host__ __device__ __forceinline__ int perm32(int rho) { const int n = rho >> 4, i = rho & 15; return 8 * (i >> 2) + 4 * n + (i & 3); }

struct Unit { int pm, pn; };
struct Gemm { const bf16_t* A; const bf16_t* Bt; int M, N, K, ld; };

struct StaticOrder {
    int nM, nN, nwg, G, c, wgm;
    __host__ __device__ void init(int M, int N, int G_, int c_, int wgm_ = WGM) { nM = M / BM; nN = N / BM; nwg = nM * nN; G = G_; c = c_; wgm = wgm_; }
    __host__ __device__ bool next(int i, Unit& u) const {
        const long L = (long)i * G + c; if (L >= nwg) return false;
        int wgid = (int)L; { const int q = nwg / NXCD, r = nwg % NXCD, xcd = wgid % NXCD, off = wgid / NXCD; wgid = (xcd < r ? xcd * (q + 1) : r * (q + 1) + (xcd - r) * q) + off; }
        const int nig = wgm * nN, gid = wgid / nig, fm = gid * wgm, gsz = (nM - fm) < wgm ? (nM - fm) : wgm;
        u.pm = fm + ((wgid % nig) % gsz); u.pn = (wgid % nig) / gsz; return true;
    }
    __device__ __forceinline__ void a_ready(const Unit&) const {}
    __device__ __forceinline__ void done(const Unit&) const {}
};

__device__ __forceinline__ unsigned cvt_pk_bf16(float lo, float hi) { unsigned r; asm volatile("v_cvt_pk_bf16_f32 %0, %1, %2" : "=v"(r) : "v"(lo), "v"(hi)); return r; }
__device__ __forceinline__ float silu_mul(float g, float u) { const float e = __builtin_amdgcn_exp2f(-1.4426950408889634f * g); return g * u * __builtin_amdgcn_rcpf(1.0f + e); }
__device__ __forceinline__ float sigmoidf_(float g) { const float e = __builtin_amdgcn_exp2f(-1.4426950408889634f * g); return __builtin_amdgcn_rcpf(1.0f + e); }
__device__ __forceinline__ float bf_lo(unsigned v) { return __uint_as_float(v << 16); }
__device__ __forceinline__ float bf_hi(unsigned v) { return __uint_as_float(v & 0xffff0000u); }
struct EpiSwiGLU {
    static constexpr bool PERM = true, AFTER_DRAIN = false;
    bf16_t* O; int ldc; const float* r2;
    __device__ __forceinline__ void operator()(const f32x4 (&acc)[2][2][4][2], const Unit& u, int wr, int wc, int fr_, int fq_) const {
        const int t_ = TIDX, fr = t_ & 15, fq = (t_ >> 4) & 3;
        const int row0 = u.pm * BM + wr * 64 + fr, col0 = u.pn * HALF + wc * 32 + 8 * fq;
#pragma unroll
        for (int ai = 0; ai < 2; ++ai)
#pragma unroll
            for (int m = 0; m < 4; ++m) {
                bf16_t* rowp = O + (size_t)(row0 + ai * HALF + m * 16) * ldc + col0;
                const f32x4 g0 = acc[ai][0][m][0], g1 = acc[ai][0][m][1], u0 = acc[ai][1][m][0], u1 = acc[ai][1][m][1];
                u32x4 w;
                w.x = cvt_pk_bf16(silu_mul(g0[0], u0[0]), silu_mul(g0[1], u0[1])); w.y = cvt_pk_bf16(silu_mul(g0[2], u0[2]), silu_mul(g0[3], u0[3]));
                w.z = cvt_pk_bf16(silu_mul(g1[0], u1[0]), silu_mul(g1[1], u1[1])); w.w = cvt_pk_bf16(silu_mul(g1[2], u1[2]), silu_mul(g1[3], u1[3]));
                st16(rowp, w);
            }
    }
};
template <bool KSUM> struct EpiBf16P {
    static constexpr bool PERM = true, AFTER_DRAIN = false;
    bf16_t* O; int ldc; float* ksum; const float* r2;
    __device__ __forceinline__ void operator()(const f32x4 (&acc)[2][2][4][2], const Unit& u, int wr, int wc, int fr_, int fq_) const {
        const int t_ = TIDX, fr = t_ & 15, fq = (t_ >> 4) & 3;
        const int row0 = u.pm * BM + wr * 64 + fr, col0 = u.pn * BM + wc * 32 + 8 * fq;
#pragma unroll
        for (int ai = 0; ai < 2; ++ai)
#pragma unroll
            for (int m = 0; m < 4; ++m) {
                bf16_t* rowp = O + (size_t)(row0 + ai * HALF + m * 16) * ldc + col0;
#pragma unroll
                for (int bj = 0; bj < 2; ++bj) { const f32x4 v0 = acc[ai][bj][m][0], v1 = acc[ai][bj][m][1];
                    u32x4 w; w.x = cvt_pk_bf16(v0[0], v0[1]); w.y = cvt_pk_bf16(v0[2], v0[3]); w.z = cvt_pk_bf16(v1[0], v1[1]); w.w = cvt_pk_bf16(v1[2], v1[3]);
                    st16(rowp + bj * HALF, w); }
            }
        if constexpr (KSUM) {
            if (u.pn >= 14 && u.pn < 17) {
#pragma unroll
                for (int bj = 0; bj < 2; ++bj)
#pragma unroll
                    for (int n = 0; n < 2; ++n) {
                        f32x4 s = (f32x4){0.f, 0.f, 0.f, 0.f};
#pragma unroll
                        for (int ai = 0; ai < 2; ++ai)
#pragma unroll
                            for (int m = 0; m < 4; ++m) s += acc[ai][bj][m][n];
#pragma unroll
                        for (int e = 0; e < 4; ++e) { float v = s[e]; v += __shfl_xor(v, 1); v += __shfl_xor(v, 2); v += __shfl_xor(v, 4); v += __shfl_xor(v, 8); s[e] = v; }
                        if (fr == 0) *(f32x4*)(ksum + (size_t)(u.pm * 2 + wr) * 768 + (u.pn - 14) * BM + bj * HALF + wc * 32 + 8 * fq + 4 * n) = s;
                    }
            }
        }
    }
};
struct EpiBf16Mul {
    static constexpr bool PERM = true, AFTER_DRAIN = false;
    bf16_t* O; int ldc; const bf16_t* E; const float* r2;
    __device__ __forceinline__ void operator()(const f32x4 (&acc)[2][2][4][2], const Unit& u, int wr, int wc, int fr_, int fq_) const {
        const int t_ = TIDX, fr = t_ & 15, fq = (t_ >> 4) & 3;
        const int row0 = u.pm * BM + wr * 64 + fr, col0 = u.pn * BM + wc * 32 + 8 * fq;
#pragma unroll
        for (int ai = 0; ai < 2; ++ai)
#pragma unroll
            for (int m = 0; m < 4; ++m) { const size_t off = (size_t)(row0 + ai * HALF + m * 16) * ldc + col0;
#pragma unroll
                for (int bj = 0; bj < 2; ++bj) { const f32x4 v0 = acc[ai][bj][m][0], v1 = acc[ai][bj][m][1];
                    const u32x4 ev = *(const u32x4*)(E + off + bj * HALF);
                    u32x4 w;
                    w.x = cvt_pk_bf16(sigmoidf_(v0[0]) * bf_lo(ev.x), sigmoidf_(v0[1]) * bf_hi(ev.x)); w.y = cvt_pk_bf16(sigmoidf_(v0[2]) * bf_lo(ev.y), sigmoidf_(v0[3]) * bf_hi(ev.y));
                    w.z = cvt_pk_bf16(sigmoidf_(v1[0]) * bf_lo(ev.z), sigmoidf_(v1[1]) * bf_hi(ev.z)); w.w = cvt_pk_bf16(sigmoidf_(v1[2]) * bf_lo(ev.w), sigmoidf_(v1[3]) * bf_hi(ev.w));
                    st16(O + off + bj * HALF, w); } }
    }
};
template <class Epi, class Sched, bool ALIGN_EPI = false, bool SP2 = false>
__device__ __forceinline__ void gemm_phase(PG8_LAS unsigned char* lds, const Gemm g, const Sched& S, const Epi& E) {
    const int tid = TIDX, wid = __builtin_amdgcn_readfirstlane(tid >> 6), lane = tid & 63, wr = wid >> 2, wc = wid & 3, fr = lane & 15, fq = lane >> 4;
    const int K = g.K, nt = K / BK, LD = g.ld;
    unsigned voffA[2], voffB[2];
#pragma unroll
    for (int i = 0; i < 2; ++i) { int R, C; stage_rc(tid * 16 + i * 8192, R, C); const int Rb = Epi::PERM ? ((R & ~31) + perm32(R & 31)) : R;
        voffA[i] = (unsigned)(R * LD + C) * 2u; voffB[i] = (unsigned)(Rb * LD + C) * 2u; }
    const size_t kstep = (size_t)(BK * 2);
    const size_t hstep = (size_t)HALF * LD * 2;
    const size_t tstep = 2 * hstep;
    const unsigned ldsw = (unsigned)wid * 1024u;
    const int aoff = lds_byte(wr * 64 + fr, fq * 8), boff = lds_byte(wc * 32 + fr, fq * 8);
#define PG8_SA(b, h) (((b) * 2 + (h)) * HTB)
#define PG8_SB(b, h) ((4 + (b) * 2 + (h)) * HTB)
#define PG8_STAGE(bufoff, gbase, voff) do { _Pragma("unroll") for (int _i = 0; _i < 2; ++_i) \
        __builtin_amdgcn_global_load_lds((const unsigned*)((const char*)(gbase) + (voff)[_i]), (PG8_LAS unsigned*)(lds + (bufoff) + ldsw + _i * 8192), 16, 0, 0); } while (0)
#define PG8_LDA(dst, b, h) do { _Pragma("unroll") for (int m = 0; m < 4; ++m) _Pragma("unroll") for (int k = 0; k < 2; ++k) dst[m][k] = *(const PG8_LAS bf16x8*)(lds + PG8_SA(b, h) + aoff + m * 2048 + k * 1024); } while (0)
#define PG8_LDB(dst, b, h) do { _Pragma("unroll") for (int n = 0; n < 2; ++n) _Pragma("unroll") for (int k = 0; k < 2; ++k) dst[n][k] = *(const PG8_LAS bf16x8*)(lds + PG8_SB(b, h) + boff + n * 2048 + k * 1024); } while (0)
#define PG8_MMA(ai, bj, At, Bt) do { __builtin_amdgcn_s_setprio(1); _Pragma("unroll") for (int m = 0; m < 4; ++m) _Pragma("unroll") for (int n = 0; n < 2; ++n) _Pragma("unroll") for (int k = 0; k < 2; ++k) \
        acc[ai][bj][m][n] = __builtin_amdgcn_mfma_f32_16x16x32_bf16(Bt[n][k], At[m][k], acc[ai][bj][m][n], 0, 0, 0); __builtin_amdgcn_s_setprio(0); } while (0)
#define PG8_WAIT_V(n) asm volatile("s_waitcnt vmcnt(" #n ")" ::: "memory")
#define PG8_WAIT_L(n) asm volatile("s_waitcnt lgkmcnt(" #n ")" ::: "memory")
#define PG8_BAR __builtin_amdgcn_s_barrier()
#define PG8_SCHED __builtin_amdgcn_sched_barrier(0)
    Unit cur, nxt; int ui = 0;
    if (!S.next(0, cur)) return;
    f32x4 acc[2][2][4][2];
#pragma unroll
    for (int a = 0; a < 2; ++a)
#pragma unroll
        for (int b = 0; b < 2; ++b)
#pragma unroll
            for (int m = 0; m < 4; ++m)
#pragma unroll
                for (int n = 0; n < 2; ++n) acc[a][b][m][n] = (f32x4){0.f, 0.f, 0.f, 0.f};
    bf16x8 At[4][2], B0[2][2], B1[2][2];
    const char* cA = (const char*)g.A + (size_t)cur.pm * tstep; const char* cB = (const char*)g.Bt + (size_t)cur.pn * tstep;
    S.a_ready(cur);
    if constexpr (SP2) {
        PG8_STAGE(PG8_SB(0, 0), cB, voffB); PG8_STAGE(PG8_SB(0, 1), cB + hstep, voffB); PG8_STAGE(PG8_SA(0, 0), cA, voffA); PG8_STAGE(PG8_SA(0, 1), cA + hstep, voffA);
        if (wr == 1) PG8_BAR;
        PG8_WAIT_V(2); PG8_BAR;
        PG8_STAGE(PG8_SB(1, 0), cB + kstep, voffB); PG8_STAGE(PG8_SA(1, 0), cA + kstep, voffA); PG8_STAGE(PG8_SB(1, 1), cB + hstep + kstep, voffB);
        PG8_WAIT_V(6); PG8_BAR;
    } else {
        PG8_STAGE(PG8_SB(0, 0), cB, voffB); PG8_STAGE(PG8_SA(0, 0), cA, voffA); PG8_STAGE(PG8_SB(0, 1), cB + hstep, voffB); PG8_STAGE(PG8_SA(0, 1), cA + hstep, voffA);
        if (wr == 1) PG8_BAR;
        PG8_WAIT_V(4); PG8_BAR;
        PG8_STAGE(PG8_SB(1, 0), cB + kstep, voffB); PG8_STAGE(PG8_SA(1, 0), cA + kstep, voffA); PG8_STAGE(PG8_SB(1, 1), cB + hstep + kstep, voffB);
        PG8_WAIT_V(6); PG8_BAR;
    }
    for (;;) {
        const bool has_next = S.next(ui + 1, nxt);
        const char* nA = has_next ? (const char*)g.A + (size_t)nxt.pm * tstep : cA; const char* nB = has_next ? (const char*)g.Bt + (size_t)nxt.pn * tstep : cB;
        for (int t = 0; t < nt; t += 2) {
            const bool last = (t == nt - 2);
            const char* a1 = cA + (size_t)(t + 1) * kstep;
            const char* a2 = last ? nA : cA + (size_t)(t + 2) * kstep; const char* b2 = last ? nB : cB + (size_t)(t + 2) * kstep;
            const char* a3 = a2 + kstep; const char* b3 = b2 + kstep;
            if (last && has_next) S.a_ready(nxt);
            if constexpr (SP2) {
            PG8_LDB(B0, 0, 0); PG8_LDB(B1, 0, 1); PG8_SCHED; PG8_LDA(At, 0, 0); PG8_STAGE(PG8_SA(1, 1), a1 + hstep, voffA);
            PG8_WAIT_V(8); PG8_WAIT_L(0); PG8_BAR; PG8_MMA(0, 0, At, B0); PG8_MMA(0, 1, At, B1); PG8_BAR; PG8_SCHED;
            PG8_LDA(At, 0, 1); PG8_STAGE(PG8_SB(0, 0), b2, voffB); PG8_STAGE(PG8_SB(0, 1), b2 + hstep, voffB); PG8_STAGE(PG8_SA(0, 0), a2, voffA);
            PG8_WAIT_V(8); PG8_WAIT_L(0); PG8_BAR; PG8_MMA(1, 0, At, B0); PG8_MMA(1, 1, At, B1); PG8_BAR; PG8_SCHED;
            PG8_LDB(B0, 1, 0); PG8_LDB(B1, 1, 1); PG8_SCHED; PG8_LDA(At, 1, 0); PG8_STAGE(PG8_SA(0, 1), a2 + hstep, voffA);
            PG8_WAIT_V(8); PG8_WAIT_L(0); PG8_BAR; PG8_MMA(0, 0, At, B0); PG8_MMA(0, 1, At, B1); PG8_BAR; PG8_SCHED;
            PG8_LDA(At, 1, 1); PG8_STAGE(PG8_SB(1, 0), b3, voffB); PG8_STAGE(PG8_SB(1, 1), b3 + hstep, voffB); PG8_STAGE(PG8_SA(1, 0), a3, voffA);
            PG8_WAIT_V(8); PG8_WAIT_L(0); PG8_BAR; PG8_MMA(1, 0, At, B0); PG8_MMA(1, 1, At, B1); PG8_BAR; PG8_SCHED;
            } else {
            PG8_LDB(B0, 0, 0); PG8_SCHED; PG8_LDA(At, 0, 0); PG8_STAGE(PG8_SA(1, 1), a1 + hstep, voffA);
            PG8_WAIT_L(8); PG8_BAR; PG8_WAIT_L(0); PG8_MMA(0, 0, At, B0); PG8_BAR; PG8_SCHED;
            PG8_LDB(B1, 0, 1); PG8_STAGE(PG8_SB(0, 0), b2, voffB);
            PG8_BAR; PG8_WAIT_L(0); PG8_MMA(0, 1, At, B1); PG8_BAR;
            PG8_LDA(At, 0, 1); PG8_STAGE(PG8_SA(0, 0), a2, voffA);
            PG8_BAR; PG8_WAIT_L(0); PG8_MMA(1, 0, At, B0); PG8_BAR; PG8_SCHED;
            PG8_STAGE(PG8_SB(0, 1), b2 + hstep, voffB);
            PG8_WAIT_V(6); PG8_BAR; PG8_MMA(1, 1, At, B1); PG8_BAR;
            PG8_LDB(B0, 1, 0); PG8_SCHED; PG8_LDA(At, 1, 0); PG8_STAGE(PG8_SA(0, 1), a2 + hstep, voffA);
            PG8_WAIT_L(8); PG8_BAR; PG8_WAIT_L(0); PG8_MMA(0, 0, At, B0); PG8_BAR; PG8_SCHED;
            PG8_LDB(B1, 1, 1); PG8_STAGE(PG8_SB(1, 0), b3, voffB);
            PG8_BAR; PG8_WAIT_L(0); PG8_MMA(0, 1, At, B1); PG8_BAR;
            PG8_LDA(At, 1, 1); PG8_STAGE(PG8_SA(1, 0), a3, voffA);
            PG8_BAR; PG8_WAIT_L(0); PG8_MMA(1, 0, At, B0); PG8_BAR; PG8_SCHED;
            PG8_STAGE(PG8_SB(1, 1), b3 + hstep, voffB);
            PG8_WAIT_V(6); PG8_BAR; PG8_MMA(1, 1, At, B1); PG8_BAR;
            }
        }
        if constexpr (ALIGN_EPI) { if (wr == 0) PG8_BAR; }
        if constexpr (!Epi::AFTER_DRAIN) { E(acc, cur, wr, wc, fr, fq); S.done(cur); }
        if (!has_next) break;
#pragma unroll
        for (int a = 0; a < 2; ++a)
#pragma unroll
            for (int b = 0; b < 2; ++b)
#pragma unroll
                for (int m = 0; m < 4; ++m)
#pragma unroll
                    for (int n = 0; n < 2; ++n) acc[a][b][m][n] = (f32x4){0.f, 0.f, 0.f, 0.f};
        cur = nxt; cA = nA; cB = nB; ++ui;
        if constexpr (ALIGN_EPI) { if (wr == 1) PG8_BAR; }
    }
    PG8_WAIT_V(0);
    if constexpr (!ALIGN_EPI) { if (wr == 0) PG8_BAR; }
    PG8_BAR;
    if constexpr (Epi::AFTER_DRAIN) { E.fused(acc, cur, wr, wc, fr, fq, lds, wid, lane); S.done(cur); }
#undef PG8_SA
#undef PG8_SB
#undef PG8_STAGE
#undef PG8_LDA
#undef PG8_LDB
#undef PG8_MMA
#undef PG8_WAIT_V
#undef PG8_WAIT_L
#undef PG8_BAR
#undef PG8_SCHED
}
}
#define LAS __attribute__((address_space(3)))
typedef unsigned short bf16_t;
typedef float f32x4 __attribute__((ext_vector_type(4)));
typedef float f32x16 __attribute__((ext_vector_type(16)));
typedef short bf16x8 __attribute__((ext_vector_type(8)));
typedef short s16x4 __attribute__((ext_vector_type(4)));
typedef unsigned u32x4 __attribute__((ext_vector_type(4)));
typedef unsigned u32x2 __attribute__((ext_vector_type(2)));

constexpr int T_ = 16384, DM = 2048, DFF = 5632, SEQ = 2048, NBAT = 8, NH = 6, HD = 128, ZW = 5120, INW = 5126, PLE = 256;
constexpr int NPH_LAYER = 14, NPHASES = 28;
constexpr float LOG2E = 1.4426950408889634f, RMS_EPS = 1e-6f;
constexpr size_t MiB = (size_t)1 << 20;
#ifndef PADU
#define PADU 64
#endif
#ifndef PADA
#define PADA 64
#endif
#ifndef PADY
#define PADY 0
#endif
constexpr int LDU = DM + PADU, LDACT = DFF + PADA, LDY = DM + PADY;
constexpr size_t al1(size_t b) { return (b + MiB - 1) / MiB * MiB; }
constexpr size_t SZ_W1 = al1((size_t)2 * DFF * LDU * 2), SZ_W2 = al1((size_t)DM * LDACT * 2), SZ_WIN = al1((size_t)ZW * LDU * 2), SZ_WO = al1((size_t)DM * LDY * 2), SZ_WG = al1((size_t)DM * LDU * 2);
constexpr size_t WS_W1A = 0, WS_W2A = WS_W1A + SZ_W1, WS_WIN = WS_W2A + SZ_W2, WS_WO = WS_WIN + SZ_WIN, WS_W1B = WS_WO + SZ_WO, WS_W2B = WS_W1B + SZ_W1, WS_WG = WS_W2B + SZ_W2, WS_WP = WS_WG + SZ_WG,
                 WS_PW = WS_WP + MiB, WS_LOGF = WS_PW + MiB, WS_KSUM = WS_LOGF + MiB, WS_PBF = WS_KSUM + MiB, WS_U = WS_PBF + 8 * MiB, WS_Y = WS_U + al1((size_t)T_ * LDU * 2), WS_E = WS_Y + al1((size_t)T_ * LDY * 2),
                 WS_F = WS_E + 64 * MiB, WS_R = WS_F + 64 * MiB, WS_CTL = WS_R + al1((size_t)T_ * LDACT * 2), WS_END = WS_CTL + MiB;
static_assert((size_t)T_ * ZW * 2 <= (size_t)T_ * LDACT * 2, "z fits the act region");
constexpr size_t WS_R2 = WS_LOGF + 512 * 1024;
constexpr int XB_LDS_OFF = 147456 - 64;
constexpr int LDS_BYTES = 147456;

struct Args { const float* in[24]; float* out; unsigned char* ws; int ph_lo, ph_hi; };
typedef const __attribute__((address_space(4))) Args* ArgsP;

#define XB_TMO      128
#define XB_XCNT(j)  (256  + 64 * (j))
#define XB_XSUB(j)  (1280 + 64 * (j))
#define XB_XGEN(j)  (2304 + 64 * (j))
#define XB_TOP      3328
#define XB_TOPGEN   3392
#define XCD_BAR_WORDS 3456
#define XB_SPIN_CAP (1u << 18)

__device__ __forceinline__ unsigned xb_ld(unsigned* p)              { return __hip_atomic_load(p, __ATOMIC_RELAXED, __HIP_MEMORY_SCOPE_AGENT); }
__device__ __forceinline__ unsigned xb_add(unsigned* p, unsigned v) { return __hip_atomic_fetch_add(p, v, __ATOMIC_RELAXED, __HIP_MEMORY_SCOPE_AGENT); }
__device__ __forceinline__ unsigned xb_xcc_id() { return (unsigned)__builtin_amdgcn_s_getreg((3 << 11) | 20) & 0xFu; }
#define XB_SPIN(cond, bar) do { unsigned _sp = 0; while (cond) { __builtin_amdgcn_s_sleep(1); \
    if ((++_sp & 255u) == 0u) { if (xb_ld(&(bar)[XB_TMO])) break; if (_sp > XB_SPIN_CAP) { atomicAdd(&(bar)[XB_TMO], 1u); break; } } } } while (0)

struct XcdBarrier {
    unsigned* bar; unsigned x;
    volatile LAS unsigned* st;
};

__device__ __forceinline__ XcdBarrier xcd_barrier_post(unsigned* bar, volatile LAS unsigned* st) {
    XcdBarrier b; b.bar = bar; b.x = xb_xcc_id(); b.st = st;
    if (threadIdx.x == 0) (void)xb_add(&bar[XB_XCNT(b.x)], 1u);
    return b;
}
__device__ __forceinline__ void xcd_barrier_complete(unsigned* bar, unsigned x, unsigned& nloc, unsigned& nx) {
    const unsigned G = gridDim.x * gridDim.y * gridDim.z;
    unsigned sum, cnt, mine, sp = 0u;
    for (;;) {
        sum = 0u; cnt = 0u; mine = 0u;
#pragma unroll
        for (unsigned j = 0; j < 16; ++j) { const unsigned c = xb_ld(&bar[XB_XCNT(j)]); sum += c; cnt += (c > 0u) ? 1u : 0u; mine = (j == x) ? c : mine; }
        if (sum == G) break;
        __builtin_amdgcn_s_sleep(1);
        if ((++sp & 255u) == 0u) { if (xb_ld(&bar[XB_TMO])) break; if (sp > XB_SPIN_CAP) { atomicAdd(&bar[XB_TMO], 1u); break; } }
    }
    nloc = mine > 0u ? mine : 1u; nx = cnt > 0u ? cnt : 1u;
}

__device__ __forceinline__ void xcd_barrier(const XcdBarrier& b) {
    asm volatile("s_waitcnt vmcnt(0)" ::: "memory");
    __syncthreads();
    if (threadIdx.x == 0) {
        unsigned* bar = b.bar;
        __builtin_amdgcn_s_waitcnt(0);
        unsigned nloc = b.st[0], nx = b.st[1];
        if (nloc == 0u) { xcd_barrier_complete(bar, b.x, nloc, nx); b.st[0] = nloc; b.st[1] = nx; }
        const unsigned old = xb_add(&bar[XB_XSUB(b.x)], 1u);
        const unsigned gen = old / nloc;
        if (old + 1u == (gen + 1u) * nloc) {
            __builtin_amdgcn_fence(__ATOMIC_RELEASE, "agent");
            asm volatile("s_waitcnt vmcnt(0)" ::: "memory");
            const unsigned og = xb_add(&bar[XB_TOP], 1u);
            const unsigned tg = og / nx;
            if (og + 1u == (tg + 1u) * nx) xb_add(&bar[XB_TOPGEN], 1u);
            else XB_SPIN(xb_ld(&bar[XB_TOPGEN]) == tg, bar);
            __builtin_amdgcn_fence(__ATOMIC_ACQUIRE, "agent");
            xb_add(&bar[XB_XGEN(b.x)], 1u);
            asm volatile("s_waitcnt vmcnt(0)" ::: "memory");
        } else {
            XB_SPIN(xb_ld(&bar[XB_XGEN(b.x)]) == gen, bar);
            __builtin_amdgcn_fence(__ATOMIC_ACQUIRE, "agent");
            asm volatile("s_waitcnt vmcnt(0)" ::: "memory");
        }
    }
    __syncthreads();
}


__device__ __forceinline__ unsigned cvtpk(float lo, float hi) { unsigned r; asm volatile("v_cvt_pk_bf16_f32 %0, %1, %2" : "=v"(r) : "v"(lo), "v"(hi)); return r; }
__device__ __forceinline__ float wave_sum(float v) {
#pragma unroll
    for (int o = 1; o < 64; o <<= 1) v += __shfl_xor(v, o);
    return v;
}
__device__ __forceinline__ float bfs2f(short s) { return __uint_as_float(((unsigned)(unsigned short)s) << 16); }
#define LDS_WAIT() asm volatile("s_waitcnt lgkmcnt(0)" ::: "memory")

__device__ __forceinline__ void conv_item(const float* W, const float* gk, int ldw, int ldt, int nsrc0, bf16_t* WT, int drow0, int kb, LAS float* scr, int lane) {
    const int k0 = 64 * kb;
    const float* wp = W + (size_t)k0 * ldw + nsrc0 + lane;
    float v[64];
#pragma unroll
    for (int i = 0; i < 64; ++i) v[i] = wp[(size_t)i * ldw];
    if (gk) {
#pragma unroll
        for (int i = 0; i < 64; ++i) v[i] *= gk[k0 + i];
    }
#pragma unroll
    for (int i = 0; i < 64; ++i) scr[i * 65 + lane] = v[i];
    LDS_WAIT(); asm volatile("" ::: "memory");
    const int c = lane & 7;
#pragma unroll
    for (int j = 0; j < 8; ++j) { const int n = (lane >> 3) + 8 * j; const LAS float* s = scr + (8 * c) * 65 + n;
        u32x4 o; o.x = cvtpk(s[0 * 65], s[1 * 65]); o.y = cvtpk(s[2 * 65], s[3 * 65]); o.z = cvtpk(s[4 * 65], s[5 * 65]); o.w = cvtpk(s[6 * 65], s[7 * 65]);
        *(u32x4*)(WT + (size_t)(drow0 + n) * ldt + k0 + 8 * c) = o; }
    LDS_WAIT(); asm volatile("" ::: "memory");
}
__device__ __forceinline__ bool conv_seg(int& it, const float* W, const float* gk, int K, int ldw, int nbeg, int ngrp, bf16_t* WT, int ldt, int mode, int row_off, LAS float* scr, int lane) {
    const int items = (K / 64) * ngrp;
    if (it >= items) { it -= items; return false; }
    const int kb = it / ngrp, nb = it % ngrp, nloc = 64 * nb;
    const int dst = (mode == 0) ? (row_off + nloc) : ((nloc >> 7) * 256 + (nloc & 127) + (mode == 2 ? 128 : 0));
    conv_item(W, gk, ldw, ldt, nbeg + nloc, WT, dst, kb, scr, lane);
    return true;
}
__device__ __forceinline__ void convert_layer(ArgsP a, LAS unsigned char* lds, int L) {
    const int tid = TIDX, lane = tid & 63, wave = __builtin_amdgcn_readfirstlane(tid >> 6);
    LAS float* scr = (LAS float*)(lds + wave * 16640);
    const int gw = blockIdx.x * 8 + wave, NGW = gridDim.x * 8;
    unsigned char* ws = a->ws;
    const size_t oFF = (size_t)L * DM * DFF, oDD = (size_t)L * DM * DM;
    constexpr int I_FF = (DM / 64) * (DFF / 64);
    constexpr int NITEMS = 6 * I_FF + 32 * 44 + 32 * 36 + 2 * (32 * 32) + 4 * 32 + 16;
    for (int it0 = gw; it0 < NITEMS; it0 += NGW) {
        int it = it0;
        if (conv_seg(it, a->in[5] + oFF, a->in[3] + (size_t)L * DM, DM, DFF, 0, DFF / 64, (bf16_t*)(ws + WS_W1A), LDU, 1, 0, scr, lane)) continue;
        if (conv_seg(it, a->in[6] + oFF, a->in[3] + (size_t)L * DM, DM, DFF, 0, DFF / 64, (bf16_t*)(ws + WS_W1A), LDU, 2, 0, scr, lane)) continue;
        if (conv_seg(it, a->in[7] + oFF, nullptr, DFF, DM, 0, DM / 64, (bf16_t*)(ws + WS_W2A), LDACT, 0, 0, scr, lane)) continue;
        if (conv_seg(it, a->in[10] + (size_t)L * DM * INW, a->in[8] + (size_t)L * DM, DM, INW, 0, 44, (bf16_t*)(ws + WS_WIN), LDU, 0, 0, scr, lane)) continue;
        if (conv_seg(it, a->in[10] + (size_t)L * DM * INW, a->in[8] + (size_t)L * DM, DM, INW, 2822, 36, (bf16_t*)(ws + WS_WIN), LDU, 0, 2816, scr, lane)) continue;
        if (conv_seg(it, a->in[14] + oDD, nullptr, DM, DM, 0, DM / 64, (bf16_t*)(ws + WS_WO), LDY, 0, 0, scr, lane)) continue;
        if (conv_seg(it, a->in[17] + oFF, a->in[15] + (size_t)L * DM, DM, DFF, 0, DFF / 64, (bf16_t*)(ws + WS_W1B), LDU, 1, 0, scr, lane)) continue;
        if (conv_seg(it, a->in[18] + oFF, a->in[15] + (size_t)L * DM, DM, DFF, 0, DFF / 64, (bf16_t*)(ws + WS_W1B), LDU, 2, 0, scr, lane)) continue;
        if (conv_seg(it, a->in[19] + oFF, nullptr, DFF, DM, 0, DM / 64, (bf16_t*)(ws + WS_W2B), LDACT, 0, 0, scr, lane)) continue;
        if (conv_seg(it, a->in[22] + oDD, a->in[20] + (size_t)L * DM, DM, DM, 0, DM / 64, (bf16_t*)(ws + WS_WG), LDU, 0, 0, scr, lane)) continue;
        if (conv_seg(it, a->in[23] + (size_t)L * PLE * DM, nullptr, PLE, DM, 0, DM / 64, (bf16_t*)(ws + WS_WP), PLE, 0, 0, scr, lane)) continue;
        { const int g = it >> 2; int r = it & 3; conv_seg(r, a->in[12] + (size_t)(L * 4 + g) * 16384, nullptr, 128, 128, 0, 2, (bf16_t*)(ws + WS_PW) + (size_t)g * 16384, 128, 0, 0, scr, lane); }
    }
    const f32x4* ps = (const f32x4*)(a->in[1] + (size_t)L * T_ * PLE);
    u32x2* pd = (u32x2*)(ws + WS_PBF);
    for (int i = blockIdx.x * 512 + tid; i < T_ * PLE / 4; i += gridDim.x * 512) { const f32x4 v = ps[i]; u32x2 o; o.x = cvtpk(v.x, v.y); o.y = cvtpk(v.z, v.w); pd[i] = o; }
}

__device__ __forceinline__ float log_sigmoidf_(float x) { return fminf(x, 0.f) - 0.6931471805599453f * __builtin_amdgcn_logf(1.0f + __builtin_amdgcn_exp2f(-1.4426950408889634f * fabsf(x))); }
__device__ __forceinline__ void rowwise(ArgsP a, LAS unsigned char* lds, const float* xin, const bf16_t* f, float alpha, const float* gpost, const float* gnext,
                                        bool forget, const float* w_in_L, const float* fbias, bool final) {
    const int tid = TIDX, lane = tid & 63, wave = __builtin_amdgcn_readfirstlane(tid >> 6);
    LAS float* wf = (LAS float*)lds;
    if (forget) {
        for (int k = tid; k < DM; k += 512) { const float* src = w_in_L + (size_t)k * INW + 2816;
#pragma unroll
            for (int j = 0; j < 6; ++j) wf[j * DM + k] = src[j]; }
        __syncthreads();
    }
    bf16_t* HB = (bf16_t*)(a->ws + WS_U);
    float* R2 = (float*)(a->ws + WS_R2);
    float* logf_out = (float*)(a->ws + WS_LOGF);
    const int gw = blockIdx.x * 8 + wave, NGW = gridDim.x * 8;
    if (xin) {
        f32x4 xn[8];
        { const f32x4* hp = (const f32x4*)(xin + (size_t)gw * DM) + lane;
#pragma unroll
          for (int j = 0; j < 8; ++j) xn[j] = hp[64 * j]; }
        for (int r = gw; r < T_; r += NGW) {
            f32x4 h[8];
#pragma unroll
            for (int j = 0; j < 8; ++j) h[j] = xn[j];
            if (r + NGW < T_) { const f32x4* hp = (const f32x4*)(xin + (size_t)(r + NGW) * DM) + lane;
#pragma unroll
                for (int j = 0; j < 8; ++j) xn[j] = hp[64 * j]; }
            float ss2 = 0.f;
#pragma unroll
            for (int j = 0; j < 8; ++j) ss2 += (h[j].x * h[j].x + h[j].y * h[j].y) + (h[j].z * h[j].z + h[j].w * h[j].w);
            ss2 = wave_sum(ss2);
            const float r2 = rsqrtf(ss2 * (1.f / DM) + RMS_EPS);
            if (lane == 0) R2[r] = r2;
            u32x2* hbp = (u32x2*)(HB + (size_t)r * LDU) + lane;
#pragma unroll
            for (int j = 0; j < 8; ++j) { u32x2 o; o.x = cvtpk(h[j].x * r2, h[j].y * r2); o.y = cvtpk(h[j].z * r2, h[j].w * r2); st8(hbp + 64 * j, o); }
        }
        return;
    }
    f32x4 gp[8], gn[8];
#pragma unroll
    for (int j = 0; j < 8; ++j) { gp[j] = ((const f32x4*)gpost)[64 * j + lane]; gn[j] = forget ? ((const f32x4*)gnext)[64 * j + lane] : (f32x4){0.f, 0.f, 0.f, 0.f}; }
    u32x2 hn[8], fn[8], hn2[8], fn2[8]; float rn = R2[gw], rn2 = 1.f;
    { const u32x2* hp = (const u32x2*)(HB + (size_t)gw * LDU) + lane; const u32x2* fp = (const u32x2*)(f + (size_t)gw * DM) + lane;
#pragma unroll
      for (int j = 0; j < 8; ++j) { hn[j] = hp[64 * j]; fn[j] = fp[64 * j]; } }
    if (gw + NGW < T_) { rn2 = R2[gw + NGW]; const u32x2* hp = (const u32x2*)(HB + (size_t)(gw + NGW) * LDU) + lane; const u32x2* fp = (const u32x2*)(f + (size_t)(gw + NGW) * DM) + lane;
#pragma unroll
      for (int j = 0; j < 8; ++j) { hn2[j] = hp[64 * j]; fn2[j] = fp[64 * j]; } }
    for (int r = gw; r < T_; r += NGW) {
        f32x4 h[8], fv[8];
        u32x2* hbp = (u32x2*)(HB + (size_t)r * LDU) + lane;
        const float ir = 1.0f / rn;
#pragma unroll
        for (int j = 0; j < 8; ++j) { h[j] = (f32x4){pg8::bf_lo(hn[j].x), pg8::bf_hi(hn[j].x), pg8::bf_lo(hn[j].y), pg8::bf_hi(hn[j].y)} * ir;
                                      fv[j] = (f32x4){pg8::bf_lo(fn[j].x), pg8::bf_hi(fn[j].x), pg8::bf_lo(fn[j].y), pg8::bf_hi(fn[j].y)}; }
        rn = rn2;
#pragma unroll
        for (int j = 0; j < 8; ++j) { hn[j] = hn2[j]; fn[j] = fn2[j]; }
        if (r + 2 * NGW < T_) { rn2 = R2[r + 2 * NGW]; const u32x2* hp = (const u32x2*)(HB + (size_t)(r + 2 * NGW) * LDU) + lane; const u32x2* fp = (const u32x2*)(f + (size_t)(r + 2 * NGW) * DM) + lane;
#pragma unroll
            for (int j = 0; j < 8; ++j) { hn2[j] = hp[64 * j]; fn2[j] = fp[64 * j]; } }
        {
            float ss = 0.f;
#pragma unroll
            for (int j = 0; j < 8; ++j) ss += (fv[j].x * fv[j].x + fv[j].y * fv[j].y) + (fv[j].z * fv[j].z + fv[j].w * fv[j].w);
            ss = wave_sum(ss);
            const float rs = alpha * rsqrtf(ss * (1.f / DM) + RMS_EPS);
#pragma unroll
            for (int j = 0; j < 8; ++j) h[j] += fv[j] * gp[j] * rs;
        }
        if (final) {
            f32x4* op = (f32x4*)(a->out + (size_t)r * DM) + lane;
#pragma unroll
            for (int j = 0; j < 8; ++j) st16(op + 64 * j, __builtin_bit_cast(u32x4, h[j]));
        } else {
            float ss2 = 0.f;
#pragma unroll
            for (int j = 0; j < 8; ++j) ss2 += (h[j].x * h[j].x + h[j].y * h[j].y) + (h[j].z * h[j].z + h[j].w * h[j].w);
            ss2 = wave_sum(ss2);
            const float r2 = rsqrtf(ss2 * (1.f / DM) + RMS_EPS);
            if (lane == 0) R2[r] = r2;
#pragma unroll
            for (int j = 0; j < 8; ++j) { h[j] = h[j] * r2; u32x2 o; o.x = cvtpk(h[j].x, h[j].y); o.y = cvtpk(h[j].z, h[j].w); st8(hbp + 64 * j, o); }
            if (forget) {
                float mine = 0.f;
#pragma unroll
                for (int j = 0; j < 8; ++j) h[j] = h[j] * gn[j];
#pragma unroll
                for (int jj = 0; jj < 6; ++jj) { float s = 0.f;
#pragma unroll
                    for (int j = 0; j < 8; ++j) { const f32x4 w = *(const LAS f32x4*)(wf + jj * DM + 256 * j + 4 * lane); s += (h[j].x * w.x + h[j].y * w.y) + (h[j].z * w.z + h[j].w * w.w); }
                    s = wave_sum(s); if (lane == jj) mine = s; }
                if (lane < 6) { const int b = r >> 11, t = r & 2047; logf_out[(size_t)(b * NH + lane) * SEQ + t] = log_sigmoidf_(mine + fbias[lane]); }
            }
        }
    }
}

namespace att {
constexpr int KSTR = 272, VSTR = 320;
constexpr int L_K = 0, L_V = 64 * KSTR, BUFB = 64 * KSTR + 64 * VSTR, L_C = 2 * BUFB, L_KM = L_C + 8192, L_LUT = L_KM + 4096, L_RED = L_LUT + 544;
typedef short v4i16_t __attribute__((ext_vector_type(4)));
__device__ __forceinline__ s16x4 vtr(const LAS unsigned char* p) { return __builtin_bit_cast(s16x4, __builtin_amdgcn_ds_read_tr16_b64_v4i16((LAS v4i16_t*)p)); }
__device__ __forceinline__ f32x16 mfma32(bf16x8 a, bf16x8 b, f32x16 c) { return __builtin_amdgcn_mfma_f32_32x32x16_bf16(a, b, c, 0, 0, 0); }
__device__ __forceinline__ f32x16 zero16() { f32x16 z;
#pragma unroll
    for (int i = 0; i < 16; ++i) z[i] = 0.f; return z; }

__device__ __forceinline__ void attn_item(LAS unsigned char* lds, const bf16_t* Z, bf16_t* Y, const float* logf, const float* ksum, const float* rel_bias,
                                          const int moba, const int b, const int h, const int qt) {
    const int tid = TIDX, lane = tid & 63, wave = __builtin_amdgcn_readfirstlane(tid >> 6), ql = lane & 31, hh = lane >> 5;
    const int qrow = 256 * qt + 32 * wave + ql;
    const size_t tok = (size_t)b * SEQ + qrow;
    const int qcol = (moba ? 2816 : 512) + h * HD, kcol = qcol + 768;
    bf16x8 qf[8];
    { const bf16_t* qp = Z + tok * ZW + qcol + 8 * hh;
#pragma unroll
      for (int kk = 0; kk < 8; ++kk) qf[kk] = *(const bf16x8*)(qp + 16 * kk); }
    LAS float* cbuf = (LAS float*)(lds + L_C);
    LAS float* kmb = (LAS float*)(lds + L_KM);
    LAS float* lut = (LAS float*)(lds + L_LUT);
    LAS float* red = (LAS float*)(lds + L_RED);
    __syncthreads();
    const int nk = 256 * (qt + 1);
    if (!moba) {
        f32x4 v = (f32x4){0.f, 0.f, 0.f, 0.f};
        if (4 * tid < nk) v = *(const f32x4*)(logf + (size_t)(b * NH + h) * SEQ + 4 * tid);
        v.y += v.x; v.z += v.y; v.w += v.z;
        const float tot = v.w; float inc = tot;
#pragma unroll
        for (int o = 1; o < 64; o <<= 1) { const float t = __shfl_up(inc, o); if (lane >= o) inc += t; }
        if (lane == 63) red[wave] = inc;
        __syncthreads();
        float base = inc - tot;
#pragma unroll
        for (int w = 0; w < 8; ++w) if (w < wave) base += red[w];
        v = (v + base) * LOG2E;
        if (4 * tid < nk) *(LAS f32x4*)(cbuf + 4 * tid) = v;
    } else {
        for (int idx = tid; idx < 1024; idx += 512) { const int j = idx >> 7, d = idx & 127; const float* p0 = ksum + (size_t)((b * 8 + j) * 2) * 768 + h * HD + d; kmb[idx] = (p0[0] + p0[768]) * (1.f / 256.f); }
        if (tid <= 128) { const int n = tid; int bk;
            if (n < 16) bk = n; else { const float nf = (float)n; bk = 16 + (int)(__builtin_amdgcn_logf(nf * 0.0625f) * (16.f / 3.f)); bk = bk < 31 ? bk : 31; }
            lut[n] = rel_bias[bk * NH + h] * LOG2E; }
    }
    __syncthreads();
    unsigned sel = 0u; float cq2 = 0.f;
    if (moba) {
        float g[7];
#pragma unroll
        for (int j = 0; j < 7; ++j) { g[j] = -INFINITY;
            if (j < qt) { float s = 0.f;
#pragma unroll
                for (int kk = 0; kk < 8; ++kk) { const LAS float* kp = kmb + j * 128 + 16 * kk + 8 * hh; const f32x4 k0 = *(const LAS f32x4*)kp, k1 = *(const LAS f32x4*)(kp + 4); const bf16x8 q = qf[kk];
                    s += bfs2f(q[0]) * k0.x + bfs2f(q[1]) * k0.y + bfs2f(q[2]) * k0.z + bfs2f(q[3]) * k0.w + bfs2f(q[4]) * k1.x + bfs2f(q[5]) * k1.y + bfs2f(q[6]) * k1.z + bfs2f(q[7]) * k1.w; }
                s += __shfl_xor(s, 32); g[j] = s; } }
#pragma unroll
        for (int j = 0; j < 7; ++j) { int cnt = 0;
#pragma unroll
            for (int i = 0; i < 7; ++i) if (i != j) cnt += ((g[i] > g[j]) || (g[i] == g[j] && i < j)) ? 1 : 0;
            if (j < qt && cnt < 3) sel |= 1u << j; }
    } else cq2 = cbuf[qrow];

    const float sc2 = 0.08838834764831845f * LOG2E;
    f32x16 o0 = zero16(), o1 = zero16(), o2 = zero16(), o3 = zero16();
    float mrun = -INFINITY, lsum = 0.f;
    const int ntiles = 4 * (qt + 1);
    const int qmin_w = 256 * qt + 32 * wave, qmax_w = qmin_w + 31;
    const int r0 = tid >> 4, ch0 = tid & 15;
    const bf16_t* kg = Z + ((size_t)b * SEQ + r0) * ZW + kcol + 8 * ch0;
    u32x4 pk0 = *(const u32x4*)kg, pk1 = *(const u32x4*)(kg + (size_t)32 * ZW), pv0 = *(const u32x4*)(kg + 768), pv1 = *(const u32x4*)(kg + (size_t)32 * ZW + 768);
    const int kwoff = r0 * KSTR + ch0 * 16, vwoff = L_V + r0 * VSTR + ch0 * 16;
    const int kroff = ql * KSTR + 16 * hh;
    const int vroff = L_V + (4 * hh + ((lane & 15) >> 2)) * VSTR + (16 * ((lane >> 4) & 1) + 4 * (lane & 3)) * 2;
    *(LAS u32x4*)(lds + kwoff) = pk0; *(LAS u32x4*)(lds + kwoff + 32 * KSTR) = pk1;
    *(LAS u32x4*)(lds + vwoff) = pv0; *(LAS u32x4*)(lds + vwoff + 32 * VSTR) = pv1;
    kg += (size_t)64 * ZW; pk0 = *(const u32x4*)kg; pk1 = *(const u32x4*)(kg + (size_t)32 * ZW); pv0 = *(const u32x4*)(kg + 768); pv1 = *(const u32x4*)(kg + (size_t)32 * ZW + 768);
    kg += (size_t)64 * ZW;
    u32x4 qk0 = *(const u32x4*)kg, qk1 = *(const u32x4*)(kg + (size_t)32 * ZW), qv0 = *(const u32x4*)(kg + 768), qv1 = *(const u32x4*)(kg + (size_t)32 * ZW + 768);
    asm volatile("s_waitcnt lgkmcnt(0)" ::: "memory"); __builtin_amdgcn_s_barrier(); asm volatile("" ::: "memory");
    for (int t = 0; t < ntiles; ++t) {
        const int cur = (t & 1) * BUFB, nxt = BUFB - cur;
        if (t + 1 < ntiles) {
            *(LAS u32x4*)(lds + nxt + kwoff) = pk0; *(LAS u32x4*)(lds + nxt + kwoff + 32 * KSTR) = pk1;
            *(LAS u32x4*)(lds + nxt + vwoff) = pv0; *(LAS u32x4*)(lds + nxt + vwoff + 32 * VSTR) = pv1;
            pk0 = qk0; pk1 = qk1; pv0 = qv0; pv1 = qv1;
            if (t + 3 < ntiles) { kg += (size_t)64 * ZW; qk0 = *(const u32x4*)kg; qk1 = *(const u32x4*)(kg + (size_t)32 * ZW); qv0 = *(const u32x4*)(kg + 768); qv1 = *(const u32x4*)(kg + (size_t)32 * ZW + 768); }
        }
        const LAS unsigned char* Kb = lds + cur; const LAS unsigned char* Vb = lds + cur;
        const int k0 = 64 * t;
        if (k0 <= qmax_w) {
            f32x16 s0 = zero16(), s1 = zero16();
#pragma unroll
            for (int kk = 0; kk < 8; ++kk) { const bf16x8 a0 = *(const LAS bf16x8*)(Kb + kroff + 32 * kk), a1 = *(const LAS bf16x8*)(Kb + kroff + 32 * KSTR + 32 * kk);
                s0 = mfma32(a0, qf[kk], s0); s1 = mfma32(a1, qf[kk], s1); }
            if (!moba) {
#pragma unroll
                for (int ig = 0; ig < 4; ++ig) { const f32x4 cb0 = *(const LAS f32x4*)(cbuf + k0 + 8 * ig + 4 * hh), cb1 = *(const LAS f32x4*)(cbuf + k0 + 32 + 8 * ig + 4 * hh);
#pragma unroll
                    for (int e = 0; e < 4; ++e) { s0[4 * ig + e] = __builtin_fmaf(s0[4 * ig + e], sc2, cq2 - cb0[e]); s1[4 * ig + e] = __builtin_fmaf(s1[4 * ig + e], sc2, cq2 - cb1[e]); } }
                if (k0 + 63 > qmin_w) {
#pragma unroll
                    for (int i = 0; i < 16; ++i) { const int key = k0 + (i & 3) + 8 * (i >> 2) + 4 * hh; if (key > qrow) s0[i] = -INFINITY; if (key + 32 > qrow) s1[i] = -INFINITY; }
                }
            } else {
                const bool past = k0 < 256 * qt;
                if (past && (k0 + 63 + 113 <= qmin_w)) {
                    const float bias = ((sel >> (k0 >> 8)) & 1u) ? lut[128] : -INFINITY;
#pragma unroll
                    for (int i = 0; i < 16; ++i) { s0[i] = __builtin_fmaf(s0[i], sc2, bias); s1[i] = __builtin_fmaf(s1[i], sc2, bias); }
                } else {
#pragma unroll
                    for (int i = 0; i < 16; ++i) { const int key = k0 + (i & 3) + 8 * (i >> 2) + 4 * hh; const int d0 = qrow - key, d1 = d0 - 32;
                        const int dd0 = d0 < 0 ? 0 : (d0 > 128 ? 128 : d0), dd1 = d1 < 0 ? 0 : (d1 > 128 ? 128 : d1);
                        float v0 = __builtin_fmaf(s0[i], sc2, lut[dd0]), v1 = __builtin_fmaf(s1[i], sc2, lut[dd1]);
                        s0[i] = d0 < 0 ? -INFINITY : v0; s1[i] = d1 < 0 ? -INFINITY : v1; }
                }
                if (past && !(k0 + 63 + 113 <= qmin_w) && !((sel >> (k0 >> 8)) & 1u)) {
#pragma unroll
                    for (int i = 0; i < 16; ++i) { s0[i] = -INFINITY; s1[i] = -INFINITY; }
                }
            }
            float tm = fmaxf(s0[0], s1[0]);
#pragma unroll
            for (int i = 1; i < 16; ++i) tm = fmaxf(tm, fmaxf(s0[i], s1[i]));
            tm = fmaxf(tm, __shfl_xor(tm, 32));
            const float mnew = fmaxf(mrun, tm);
            const float muse = (mnew == -INFINITY) ? 0.f : mnew;
            const float alpha = __builtin_amdgcn_exp2f(mrun - muse);
            mrun = mnew;
            float ps = 0.f;
#pragma unroll
            for (int i = 0; i < 16; ++i) { s0[i] = __builtin_amdgcn_exp2f(s0[i] - muse); s1[i] = __builtin_amdgcn_exp2f(s1[i] - muse); ps += s0[i] + s1[i]; }
            lsum = lsum * alpha + ps;
            o0 *= alpha; o1 *= alpha; o2 *= alpha; o3 *= alpha;
            bf16x8 pb[4];
            { u32x4 w;
              w.x = cvtpk(s0[0], s0[1]); w.y = cvtpk(s0[2], s0[3]); w.z = cvtpk(s0[4], s0[5]); w.w = cvtpk(s0[6], s0[7]); pb[0] = __builtin_bit_cast(bf16x8, w);
              w.x = cvtpk(s0[8], s0[9]); w.y = cvtpk(s0[10], s0[11]); w.z = cvtpk(s0[12], s0[13]); w.w = cvtpk(s0[14], s0[15]); pb[1] = __builtin_bit_cast(bf16x8, w);
              w.x = cvtpk(s1[0], s1[1]); w.y = cvtpk(s1[2], s1[3]); w.z = cvtpk(s1[4], s1[5]); w.w = cvtpk(s1[6], s1[7]); pb[2] = __builtin_bit_cast(bf16x8, w);
              w.x = cvtpk(s1[8], s1[9]); w.y = cvtpk(s1[10], s1[11]); w.z = cvtpk(s1[12], s1[13]); w.w = cvtpk(s1[14], s1[15]); pb[3] = __builtin_bit_cast(bf16x8, w); }
#pragma unroll
            for (int c = 0; c < 4; ++c) {
                const LAS unsigned char* vp = Vb + vroff + (16 * c) * VSTR;
#define ATT_PV(db, od) { const s16x4 lo = vtr(vp + 64 * (db)), hi = vtr(vp + 8 * VSTR + 64 * (db)); const bf16x8 A = __builtin_shufflevector(lo, hi, 0, 1, 2, 3, 4, 5, 6, 7); od = mfma32(A, pb[c], od); }
                ATT_PV(0, o0) ATT_PV(1, o1) ATT_PV(2, o2) ATT_PV(3, o3)
#undef ATT_PV
            }
        }
        asm volatile("s_waitcnt lgkmcnt(0)" ::: "memory"); __builtin_amdgcn_s_barrier(); asm volatile("" ::: "memory");
    }
    lsum += __shfl_xor(lsum, 32);
    const float inv = 1.f / lsum;
    bf16_t* yp = Y + tok * LDY + (moba ? 1280 : 512) + h * HD + 4 * hh;
#define ATT_ST(db, od) { _Pragma("unroll") for (int ig = 0; ig < 4; ++ig) { u32x2 w; w.x = cvtpk(od[4 * ig] * inv, od[4 * ig + 1] * inv); w.y = cvtpk(od[4 * ig + 2] * inv, od[4 * ig + 3] * inv); st8(yp + 32 * (db) + 8 * ig, w); } }
    ATT_ST(0, o0) ATT_ST(1, o1) ATT_ST(2, o2) ATT_ST(3, o3)
#undef ATT_ST
}

__device__ __forceinline__ void pool_item(LAS unsigned char* lds, const bf16_t* Z, bf16_t* Y, const bf16_t* PW, const float* pscale, const int tile, const int g) {
    const int tid = TIDX, lane = tid & 63, wave = __builtin_amdgcn_readfirstlane(tid >> 6), ql = lane & 31, hh = lane >> 5;
    const int tok0 = tile * 256;
    constexpr int VST = 69632;
    __syncthreads();
    const bool first = (tok0 & 2047) == 0;
    {
        u32x4 sv[9];
#pragma unroll
        for (int i = 0; i < 9; ++i) { const int c = tid + 512 * i, row = c >> 4, ch = c & 15;
            sv[i] = (u32x4){0u, 0u, 0u, 0u};
            if (c < 271 * 16 && !(first && row < 15)) sv[i] = *(const u32x4*)(Z + (size_t)(tok0 - 15 + row) * ZW + g * 128 + 8 * ch); }
#pragma unroll
        for (int i = 0; i < 9; ++i) { const int c = tid + 512 * i, row = c >> 4, ch = c & 15;
            if (c < 271 * 16) *(LAS u32x4*)(lds + VST + row * 272 + 16 * ch) = sv[i]; }
    }
    __syncthreads();
    { const int cp = tid & 63, seg = tid >> 6;
#define POOL_ROWS(W) \
      for (int i = 0; i < 32; ++i) { const int row = 32 * seg + i, pos = (tok0 + row) & 2047; \
        const int cnt = (pos + 1 < (W)) ? pos + 1 : (W); \
        const LAS unsigned char* vp = lds + VST + (row + 15) * 272 + 4 * cp; \
        float s0 = 0.f, s1 = 0.f; \
        _Pragma("unroll") for (int sft = (W) - 1; sft >= 0; --sft) { const unsigned v = *(const LAS unsigned*)(vp - sft * 272); if (sft < cnt) { s0 += pg8::bf_lo(v); s1 += pg8::bf_hi(v); } } \
        const unsigned vc = *(const LAS unsigned*)vp; \
        const float fc = (float)cnt; \
        *(LAS unsigned*)(lds + row * 272 + 4 * cp) = cvtpk(s0 / fc - pg8::bf_lo(vc), s1 / fc - pg8::bf_hi(vc)); }
      if (g == 0) { POOL_ROWS(2) } else if (g == 1) { POOL_ROWS(4) } else if (g == 2) { POOL_ROWS(8) } else { POOL_ROWS(16) }
#undef POOL_ROWS
    }
    __syncthreads();
    bf16x8 bfr[8];
#pragma unroll
    for (int kk = 0; kk < 8; ++kk) bfr[kk] = *(const LAS bf16x8*)(lds + (32 * wave + ql) * 272 + 32 * kk + 16 * hh);
    const size_t tok = (size_t)tok0 + 32 * wave + ql;
    bf16x8 wa[4][8];
#pragma unroll
    for (int nb = 0; nb < 4; ++nb) { const bf16_t* wp = PW + (size_t)g * 16384 + (32 * nb + ql) * 128 + 8 * hh;
#pragma unroll
        for (int kk = 0; kk < 8; ++kk) wa[nb][kk] = *(const bf16x8*)(wp + 16 * kk); }
#pragma unroll
    for (int nb = 0; nb < 4; ++nb) {
        f32x16 acc = zero16();
#pragma unroll
        for (int kk = 0; kk < 8; ++kk) acc = mfma32(wa[nb][kk], bfr[kk], acc);
#pragma unroll
        for (int ig = 0; ig < 4; ++ig) { const f32x4 sc = *(const f32x4*)(pscale + g * 128 + 32 * nb + 8 * ig + 4 * hh);
            u32x2 o; o.x = cvtpk(acc[4 * ig] * sc.x, acc[4 * ig + 1] * sc.y); o.y = cvtpk(acc[4 * ig + 2] * sc.z, acc[4 * ig + 3] * sc.w);
            st8(Y + tok * LDY + g * 128 + 32 * nb + 8 * ig + 4 * hh, o); }
    }
}
}

__device__ __forceinline__ void attn_phase(ArgsP a, LAS unsigned char* lds, int L) {
    const bf16_t* Z = (const bf16_t*)(a->ws + WS_R); bf16_t* Y = (bf16_t*)(a->ws + WS_Y);
    const float* logf = (const float*)(a->ws + WS_LOGF); const float* ksum = (const float*)(a->ws + WS_KSUM);
    const int blk = blockIdx.x, G = gridDim.x;
    const int nrounds = (G == 256) ? 3 : (768 + G - 1) / G;
    for (int r = 0; r < nrounds; ++r) {
        const int e = (G == 256) ? ((r == 0) ? blk : (r == 1 ? 511 - blk : 512 + (blk ^ 1))) : (blk + r * G);
        if (e >= 768) break;
        const int qt = 7 - e / 96, rest = e % 96, moba = rest & 1, bh = rest >> 1;
        att::attn_item(lds, Z, Y, logf, ksum, a->in[2], moba, bh / 6, bh % 6, qt);
    }
    for (int pi = blk; pi < 256; pi += G) att::pool_item(lds, Z, Y, (const bf16_t*)(a->ws + WS_PW), a->in[13] + (size_t)L * 512, pi >> 2, pi & 3);
}

#ifndef WGM_N2048
#define WGM_N2048 4
#endif
template <class Epi> __device__ __forceinline__ void run_gemm(LAS unsigned char* lds, const bf16_t* A, const bf16_t* Bt, int N, int K, int ld, const Epi& E) {
    pg8::Gemm g{A, Bt, T_, N, K, ld}; pg8::StaticOrder S; S.init(T_, N, (int)gridDim.x, (int)blockIdx.x, (N == DM) ? WGM_N2048 : 8);
    pg8::gemm_phase<Epi, pg8::StaticOrder, true, true>(lds, g, S, E);
}

__device__ __forceinline__ void run_phase(ArgsP a, LAS unsigned char* lds, const int ph) {
    const int L = ph / NPH_LAYER, k = ph % NPH_LAYER;
    unsigned char* ws = a->ws;
    bf16_t* U = (bf16_t*)(ws + WS_U); bf16_t* Y = (bf16_t*)(ws + WS_Y); bf16_t* R = (bf16_t*)(ws + WS_R); bf16_t* E = (bf16_t*)(ws + WS_E);
    bf16_t* F = (bf16_t*)(ws + WS_F);
    const size_t oG = (size_t)L * DM;
#ifndef PHSEL
#define PHSEL 0xFFFF
#endif
    if ((PHSEL & 1) && k == 0) {
        convert_layer(a, lds, L);
        if (L == 0) { __syncthreads(); rowwise(a, lds, a->in[0], nullptr, 0.f, nullptr, nullptr, false, nullptr, nullptr, false); }
    } else if ((PHSEL & 2) && (k == 1 || k == 8)) {
        pg8::EpiSwiGLU Ep{R, LDACT, (const float*)(ws + WS_R2)};
        run_gemm(lds, U, (const bf16_t*)(ws + (k == 1 ? WS_W1A : WS_W1B)), 2 * DFF, DM, LDU, Ep);
    } else if ((PHSEL & 4) && (k == 2 || k == 6 || k == 9 || k == 10)) {
        pg8::EpiBf16P<false> Ep{(k == 10) ? E : F, DM, nullptr, nullptr};
        const bf16_t* A = (k == 6) ? Y : ((k == 10) ? (const bf16_t*)(ws + WS_PBF) : R);
        const bf16_t* Bt = (const bf16_t*)(ws + (k == 2 ? WS_W2A : (k == 6 ? WS_WO : (k == 9 ? WS_W2B : WS_WP))));
        run_gemm(lds, A, Bt, DM, (k == 6) ? DM : ((k == 10) ? PLE : DFF), (k == 6) ? LDY : ((k == 10) ? PLE : LDACT), Ep);
    } else if ((PHSEL & 8) && k == 4) {
        pg8::EpiBf16P<true> Ep{R, ZW, (float*)(ws + WS_KSUM), (const float*)(ws + WS_R2)};
        run_gemm(lds, U, (const bf16_t*)(ws + WS_WIN), ZW, DM, LDU, Ep);
    } else if ((PHSEL & 16) && k == 5) {
        attn_phase(a, lds, L);
    } else if ((PHSEL & 32) && k == 12) {
        pg8::EpiBf16Mul Ep{F, DM, E, (const float*)(ws + WS_R2)};
        run_gemm(lds, U, (const bf16_t*)(ws + WS_WG), DM, DM, LDU, Ep);
    } else if ((PHSEL & 64) && k == 3) {
        rowwise(a, lds, nullptr, F, 0.5f, a->in[4] + oG, a->in[8] + oG, true, a->in[10] + (size_t)L * DM * INW, a->in[11] + L * NH, false);
    } else if ((PHSEL & 128) && k == 7) {
        rowwise(a, lds, nullptr, F, 1.0f, a->in[9] + oG, nullptr, false, nullptr, nullptr, false);
    } else if ((PHSEL & 256) && k == 11) {
        rowwise(a, lds, nullptr, F, 0.5f, a->in[16] + oG, nullptr, false, nullptr, nullptr, false);
    } else if (PHSEL & 512) {
        rowwise(a, lds, nullptr, F, 1.0f, a->in[21] + oG, nullptr, false, nullptr, nullptr, L == 1);
    }
}

__global__ void __launch_bounds__(512, 2) fwd_kernel(Args a) {
    extern __shared__ __attribute__((aligned(16))) unsigned char lds_raw[];
    LAS unsigned char* lds = (LAS unsigned char*)lds_raw;
    cg::grid_group grid = cg::this_grid();
    if (threadIdx.x < 2) ((volatile LAS unsigned*)(lds + XB_LDS_OFF))[threadIdx.x] = 0u;
    __syncthreads();
    (void)xcd_barrier_post((unsigned*)(a.ws + WS_CTL), (volatile LAS unsigned*)(lds + XB_LDS_OFF));
    for (int ph = a.ph_lo; ph < a.ph_hi; ++ph) {
        ArgsP ap = (ArgsP)__builtin_amdgcn_kernarg_segment_ptr();
        asm volatile("" : "+s"(ap));
        run_phase(ap, lds, ph);
        if (ph + 1 < a.ph_hi) { if (ph == a.ph_lo) grid.sync(); else { XcdBarrier bar; bar.bar = (unsigned*)(ap->ws + WS_CTL); bar.x = xb_xcc_id(); bar.st = (volatile LAS unsigned*)(lds + XB_LDS_OFF); xcd_barrier(bar); } }
    }
}

extern "C" void kernel_launch(void* const* d_in, const int* in_sizes, int n_in, void* d_out, int out_size, void* d_ws, size_t ws_size, hipStream_t stream) {
    static int grid = 0;
    if (grid == 0) {
        if (n_in != 24 || out_size != T_ * DM || ws_size < WS_END) { fprintf(stderr, "kernel_launch: unexpected shapes: n_in %d out %d ws %zu (need %zu)\n", n_in, out_size, ws_size, (size_t)WS_END); grid = -1; return; }
        int dev = 0, cus = 0, per_cu = 0;
        hipGetDevice(&dev); hipDeviceGetAttribute(&cus, hipDeviceAttributeMultiprocessorCount, dev);
        if (hipFuncSetAttribute((const void*)fwd_kernel, hipFuncAttributeMaxDynamicSharedMemorySize, LDS_BYTES) != hipSuccess) { fprintf(stderr, "kernel_launch: hipFuncSetAttribute failed\n"); }
        if (hipOccupancyMaxActiveBlocksPerMultiprocessor(&per_cu, (const void*)fwd_kernel, 512, LDS_BYTES) != hipSuccess || per_cu < 1) per_cu = 1;
        (void)hipGetLastError();
        grid = cus * per_cu;
        if (grid <= 0) grid = 256;
    }
    if (grid < 0) return;
    if (hipMemsetAsync((char*)d_ws + WS_CTL, 0, 16384, stream) != hipSuccess) { fprintf(stderr, "kernel_launch: memset failed\n"); return; }
    Args a{};
    for (int i = 0; i < 24; ++i) a.in[i] = (const float*)d_in[i];
    a.out = (float*)d_out; a.ws = (unsigned char*)d_ws;
#if N_LAUNCH_MODE == 1
    a.ph_lo = 0; a.ph_hi = NPHASES;
    void* args[] = {&a};
    hipError_t e = hipLaunchCooperativeKernel((const void*)fwd_kernel, dim3(grid), dim3(512), args, LDS_BYTES, stream);
    if (e != hipSuccess) fprintf(stderr, "cooperative launch failed: %s (grid %d)\n", hipGetErrorString(e), grid);
#else
    for (int ph = 0; ph < NPHASES; ++ph) {
        a.ph_lo = ph; a.ph_hi = ph + 1;
        void* args[] = {&a};
        hipError_t e = hipLaunchCooperativeKernel((const void*)fwd_kernel, dim3(grid), dim3(512), args, LDS_BYTES, stream);
        if (e != hipSuccess) { fprintf(stderr, "launch %d failed: %s (grid %d)\n", ph, hipGetErrorString(e), grid); break; }
    }
#endif
}
```

```cpp
#include <hip/hip_runtime.h>
#include <hip/hip_cooperative_groups.h>
#include <cstdio>
#include <cstdint>
namespace cg = cooperative_groups;
__device__ __forceinline__ int tid_launder() { int t = threadIdx.x; asm volatile("" : "+v"(t)); return t; }
#define TIDX tid_launder()
#define DPP_F(old, v, ctrl, row_mask, bc) __builtin_bit_cast(float, __builtin_amdgcn_update_dpp(__builtin_bit_cast(int, (float)(old)), __builtin_bit_cast(int, (float)(v)), (ctrl), (row_mask), 0xF, (bc)))
__device__ __forceinline__ float row_sum16(float v) {
    v += DPP_F(0.f, v, 0xB1, 0xF, true);
    v += DPP_F(0.f, v, 0x4E, 0xF, true);
    v += DPP_F(0.f, v, 0x141, 0xF, true);
    v += DPP_F(0.f, v, 0x140, 0xF, true);
    return v; }
__device__ __forceinline__ float wave_sum_dpp(float v) {
    v = row_sum16(v);
    v += DPP_F(0.f, v, 0x142, 0xA, false);
    v += DPP_F(0.f, v, 0x143, 0xC, false);
    return __builtin_bit_cast(float, __builtin_amdgcn_readlane(__builtin_bit_cast(int, v), 63)); }
#ifndef WT_STORES
#define WT_STORES 0
#endif
typedef unsigned wt_u32x4 __attribute__((ext_vector_type(4)));
typedef unsigned wt_u32x2 __attribute__((ext_vector_type(2)));
__device__ __forceinline__ void st16(void* p, wt_u32x4 v) {
#if WT_STORES
    asm volatile("global_store_dwordx4 %0, %1, off sc1\n\ts_nop 1" :: "v"(p), "v"(v) : "memory");
#else
    *(wt_u32x4*)p = v;
#endif
}
__device__ __forceinline__ void st8(void* p, wt_u32x2 v) {
#if WT_STORES
    asm volatile("global_store_dwordx2 %0, %1, off sc1\n\ts_nop 1" :: "v"(p), "v"(v) : "memory");
#else
    *(wt_u32x2*)p = v;
#endif
}
#ifndef N_LAUNCH_MODE
#define N_LAUNCH_MODE 1
#endif
namespace pg8 {
#define PG8_LAS __attribute__((address_space(3)))
typedef unsigned short bf16_t;
typedef short bf16x8 __attribute__((ext_vector_type(8)));
typedef float f32x4 __attribute__((ext_vector_type(4)));
typedef unsigned u32x4 __attribute__((ext_vector_type(4)));
constexpr int BM = 256, BK = 64, HALF = 128, HTB = HALF * BK * 2  , STAGE_BYTES = 8 * HTB, NXCD = 8, WGM = 8;

__host__ __device__ __forceinline__ int lds_byte(int r, int c) { const int st = (r >> 4) * 2 + (c >> 5), rr = r & 15, cc = c & 31, ob = rr * 64 + cc * 2; return st * 1024 + (ob ^ (((ob >> 9) & 1) << 5)); }
__host__ __device__ __forceinline__ void stage_rc(int b, int& R, int& C) { const int st = b / 1024, sb = b % 1024, swz = sb ^ (((sb >> 9) & 1) << 5); R = (st >> 1) * 16 + swz / 64; C = (st & 1) * 32 + (swz % 64) / 2; }
__host__ __device__ __forceinline__ int perm32(int rho) { const int n = rho >> 4, i = rho & 15; return 8 * (i >> 2) + 4 * n + (i & 3); }

struct Unit { int pm, pn; };
struct Gemm { const bf16_t* A; const bf16_t* Bt; int M, N, K, ld; };

struct StaticOrder {
    int nM, nN, nwg, G, c, wgm;
    __host__ __device__ void init(int M, int N, int G_, int c_, int wgm_ = WGM) { nM = M / BM; nN = N / BM; nwg = nM * nN; G = G_; c = c_; wgm = wgm_; }
    __host__ __device__ bool next(int i, Unit& u) const {
        const long L = (long)i * G + c; if (L >= nwg) return false;
        int wgid = (int)L; { const int q = nwg / NXCD, r = nwg % NXCD, xcd = wgid % NXCD, off = wgid / NXCD; wgid = (xcd < r ? xcd * (q + 1) : r * (q + 1) + (xcd - r) * q) + off; }
        const int nig = wgm * nN, gid = wgid / nig, fm = gid * wgm, gsz = (nM - fm) < wgm ? (nM - fm) : wgm;
        u.pm = fm + ((wgid % nig) % gsz); u.pn = (wgid % nig) / gsz; return true;
    }
    __device__ __forceinline__ void a_ready(const Unit&) const {}
    __device__ __forceinline__ void done(const Unit&) const {}
};

__device__ __forceinline__ unsigned cvt_pk_bf16(float lo, float hi) { unsigned r; asm volatile("v_cvt_pk_bf16_f32 %0, %1, %2" : "=v"(r) : "v"(lo), "v"(hi)); return r; }
__device__ __forceinline__ float silu_mul(float g, float u) { const float e = __builtin_amdgcn_exp2f(-1.4426950408889634f * g); return g * u * __builtin_amdgcn_rcpf(1.0f + e); }
__device__ __forceinline__ float sigmoidf_(float g) { const float e = __builtin_amdgcn_exp2f(-1.4426950408889634f * g); return __builtin_amdgcn_rcpf(1.0f + e); }
__device__ __forceinline__ float bf_lo(unsigned v) { return __uint_as_float(v << 16); }
__device__ __forceinline__ float bf_hi(unsigned v) { return __uint_as_float(v & 0xffff0000u); }
struct EpiSwiGLU {
    static constexpr bool PERM = true, AFTER_DRAIN = false;
    bf16_t* O; int ldc; const float* r2;
    __device__ __forceinline__ void operator()(const f32x4 (&acc)[2][2][4][2], const Unit& u, int wr, int wc, int fr_, int fq_) const {
        const int t_ = TIDX, fr = t_ & 15, fq = (t_ >> 4) & 3;
        const int row0 = u.pm * BM + wr * 64 + fr, col0 = u.pn * HALF + wc * 32 + 8 * fq;
#pragma unroll
        for (int ai = 0; ai < 2; ++ai)
#pragma unroll
            for (int m = 0; m < 4; ++m) {
                bf16_t* rowp = O + (size_t)(row0 + ai * HALF + m * 16) * ldc + col0;
                const f32x4 g0 = acc[ai][0][m][0], g1 = acc[ai][0][m][1], u0 = acc[ai][1][m][0], u1 = acc[ai][1][m][1];
                u32x4 w;
                w.x = cvt_pk_bf16(silu_mul(g0[0], u0[0]), silu_mul(g0[1], u0[1])); w.y = cvt_pk_bf16(silu_mul(g0[2], u0[2]), silu_mul(g0[3], u0[3]));
                w.z = cvt_pk_bf16(silu_mul(g1[0], u1[0]), silu_mul(g1[1], u1[1])); w.w = cvt_pk_bf16(silu_mul(g1[2], u1[2]), silu_mul(g1[3], u1[3]));
                st16(rowp, w);
            }
    }
};
template <bool KSUM> struct EpiBf16P {
    static constexpr bool PERM = true, AFTER_DRAIN = false;
    bf16_t* O; int ldc; float* ksum; const float* r2;
    __device__ __forceinline__ void operator()(const f32x4 (&acc)[2][2][4][2], const Unit& u, int wr, int wc, int fr_, int fq_) const {
        const int t_ = TIDX, fr = t_ & 15, fq = (t_ >> 4) & 3;
        const int row0 = u.pm * BM + wr * 64 + fr, col0 = u.pn * BM + wc * 32 + 8 * fq;
#pragma unroll
        for (int ai = 0; ai < 2; ++ai)
#pragma unroll
            for (int m = 0; m < 4; ++m) {
                bf16_t* rowp = O + (size_t)(row0 + ai * HALF + m * 16) * ldc + col0;
#pragma unroll
                for (int bj = 0; bj < 2; ++bj) { const f32x4 v0 = acc[ai][bj][m][0], v1 = acc[ai][bj][m][1];
                    u32x4 w; w.x = cvt_pk_bf16(v0[0], v0[1]); w.y = cvt_pk_bf16(v0[2], v0[3]); w.z = cvt_pk_bf16(v1[0], v1[1]); w.w = cvt_pk_bf16(v1[2], v1[3]);
                    st16(rowp + bj * HALF, w); }
            }
        if constexpr (KSUM) {
            if (u.pn >= 14 && u.pn < 17) {
#pragma unroll
                for (int bj = 0; bj < 2; ++bj)
#pragma unroll
                    for (int n = 0; n < 2; ++n) {
                        f32x4 s = (f32x4){0.f, 0.f, 0.f, 0.f};
#pragma unroll
                        for (int ai = 0; ai < 2; ++ai)
#pragma unroll
                            for (int m = 0; m < 4; ++m) s += acc[ai][bj][m][n];
#pragma unroll
                        for (int e = 0; e < 4; ++e) s[e] = row_sum16(s[e]);
                        if (fr == 0) *(f32x4*)(ksum + (size_t)(u.pm * 2 + wr) * 768 + (u.pn - 14) * BM + bj * HALF + wc * 32 + 8 * fq + 4 * n) = s;
                    }
            }
        }
    }
};
struct EpiBf16Mul {
    static constexpr bool PERM = true, AFTER_DRAIN = false;
    bf16_t* O; int ldc; const bf16_t* E; const float* r2;
    __device__ __forceinline__ void operator()(const f32x4 (&acc)[2][2][4][2], const Unit& u, int wr, int wc, int fr_, int fq_) const {
        const int t_ = TIDX, fr = t_ & 15, fq = (t_ >> 4) & 3;
        const int row0 = u.pm * BM + wr * 64 + fr, col0 = u.pn * BM + wc * 32 + 8 * fq;
#pragma unroll
        for (int ai = 0; ai < 2; ++ai)
#pragma unroll
            for (int m = 0; m < 4; ++m) { const size_t off = (size_t)(row0 + ai * HALF + m * 16) * ldc + col0;
#pragma unroll
                for (int bj = 0; bj < 2; ++bj) { const f32x4 v0 = acc[ai][bj][m][0], v1 = acc[ai][bj][m][1];
                    const u32x4 ev = *(const u32x4*)(E + off + bj * HALF);
                    u32x4 w;
                    w.x = cvt_pk_bf16(sigmoidf_(v0[0]) * bf_lo(ev.x), sigmoidf_(v0[1]) * bf_hi(ev.x)); w.y = cvt_pk_bf16(sigmoidf_(v0[2]) * bf_lo(ev.y), sigmoidf_(v0[3]) * bf_hi(ev.y));
                    w.z = cvt_pk_bf16(sigmoidf_(v1[0]) * bf_lo(ev.z), sigmoidf_(v1[1]) * bf_hi(ev.z)); w.w = cvt_pk_bf16(sigmoidf_(v1[2]) * bf_lo(ev.w), sigmoidf_(v1[3]) * bf_hi(ev.w));
                    st16(O + off + bj * HALF, w); } }
    }
};
template <class Epi, class Sched, bool ALIGN_EPI = false, bool SP2 = false>
__device__ __forceinline__ void gemm_phase(PG8_LAS unsigned char* lds, const Gemm g, const Sched& S, const Epi& E) {
    const int tid = TIDX, wid = __builtin_amdgcn_readfirstlane(tid >> 6), lane = tid & 63, wr = wid >> 2, wc = wid & 3, fr = lane & 15, fq = lane >> 4;
    const int K = g.K, nt = K / BK, LD = g.ld;
    unsigned voffA[2], voffB[2];
#pragma unroll
    for (int i = 0; i < 2; ++i) { int R, C; stage_rc(tid * 16 + i * 8192, R, C); const int Rb = Epi::PERM ? ((R & ~31) + perm32(R & 31)) : R;
        voffA[i] = (unsigned)(R * LD + C) * 2u; voffB[i] = (unsigned)(Rb * LD + C) * 2u; }
    const size_t kstep = (size_t)(BK * 2);
    const size_t hstep = (size_t)HALF * LD * 2;
    const size_t tstep = 2 * hstep;
    const unsigned ldsw = (unsigned)wid * 1024u;
    const int aoff = lds_byte(wr * 64 + fr, fq * 8), boff = lds_byte(wc * 32 + fr, fq * 8);
#define PG8_SA(b, h) (((b) * 2 + (h)) * HTB)
#define PG8_SB(b, h) ((4 + (b) * 2 + (h)) * HTB)
#define PG8_STAGE(bufoff, gbase, voff) do { _Pragma("unroll") for (int _i = 0; _i < 2; ++_i) \
        __builtin_amdgcn_global_load_lds((const unsigned*)((const char*)(gbase) + (voff)[_i]), (PG8_LAS unsigned*)(lds + (bufoff) + ldsw + _i * 8192), 16, 0, 0); } while (0)
#define PG8_LDA(dst, b, h) do { _Pragma("unroll") for (int m = 0; m < 4; ++m) _Pragma("unroll") for (int k = 0; k < 2; ++k) dst[m][k] = *(const PG8_LAS bf16x8*)(lds + PG8_SA(b, h) + aoff + m * 2048 + k * 1024); } while (0)
#define PG8_LDB(dst, b, h) do { _Pragma("unroll") for (int n = 0; n < 2; ++n) _Pragma("unroll") for (int k = 0; k < 2; ++k) dst[n][k] = *(const PG8_LAS bf16x8*)(lds + PG8_SB(b, h) + boff + n * 2048 + k * 1024); } while (0)
#define PG8_MMA(ai, bj, At, Bt) do { __builtin_amdgcn_s_setprio(1); _Pragma("unroll") for (int m = 0; m < 4; ++m) _Pragma("unroll") for (int n = 0; n < 2; ++n) _Pragma("unroll") for (int k = 0; k < 2; ++k) \
        acc[ai][bj][m][n] = __builtin_amdgcn_mfma_f32_16x16x32_bf16(Bt[n][k], At[m][k], acc[ai][bj][m][n], 0, 0, 0); __builtin_amdgcn_s_setprio(0); } while (0)
#define PG8_WAIT_V(n) asm volatile("s_waitcnt vmcnt(" #n ")" ::: "memory")
#define PG8_WAIT_L(n) asm volatile("s_waitcnt lgkmcnt(" #n ")" ::: "memory")
#define PG8_BAR __builtin_amdgcn_s_barrier()
#define PG8_SCHED __builtin_amdgcn_sched_barrier(0)
    Unit cur, nxt; int ui = 0;
    if (!S.next(0, cur)) return;
    f32x4 acc[2][2][4][2];
#pragma unroll
    for (int a = 0; a < 2; ++a)
#pragma unroll
        for (int b = 0; b < 2; ++b)
#pragma unroll
            for (int m = 0; m < 4; ++m)
#pragma unroll
                for (int n = 0; n < 2; ++n) acc[a][b][m][n] = (f32x4){0.f, 0.f, 0.f, 0.f};
    bf16x8 At[4][2], B0[2][2], B1[2][2];
    const char* cA = (const char*)g.A + (size_t)cur.pm * tstep; const char* cB = (const char*)g.Bt + (size_t)cur.pn * tstep;
    S.a_ready(cur);
    if constexpr (SP2) {
        PG8_STAGE(PG8_SB(0, 0), cB, voffB); PG8_STAGE(PG8_SB(0, 1), cB + hstep, voffB); PG8_STAGE(PG8_SA(0, 0), cA, voffA); PG8_STAGE(PG8_SA(0, 1), cA + hstep, voffA);
        if (wr == 1) PG8_BAR;
        PG8_WAIT_V(2); PG8_BAR;
        PG8_STAGE(PG8_SB(1, 0), cB + kstep, voffB); PG8_STAGE(PG8_SA(1, 0), cA + kstep, voffA); PG8_STAGE(PG8_SB(1, 1), cB + hstep + kstep, voffB);
        PG8_WAIT_V(6); PG8_BAR;
    } else {
        PG8_STAGE(PG8_SB(0, 0), cB, voffB); PG8_STAGE(PG8_SA(0, 0), cA, voffA); PG8_STAGE(PG8_SB(0, 1), cB + hstep, voffB); PG8_STAGE(PG8_SA(0, 1), cA + hstep, voffA);
        if (wr == 1) PG8_BAR;
        PG8_WAIT_V(4); PG8_BAR;
        PG8_STAGE(PG8_SB(1, 0), cB + kstep, voffB); PG8_STAGE(PG8_SA(1, 0), cA + kstep, voffA); PG8_STAGE(PG8_SB(1, 1), cB + hstep + kstep, voffB);
        PG8_WAIT_V(6); PG8_BAR;
    }
    for (;;) {
        const bool has_next = S.next(ui + 1, nxt);
        const char* nA = has_next ? (const char*)g.A + (size_t)nxt.pm * tstep : cA; const char* nB = has_next ? (const char*)g.Bt + (size_t)nxt.pn * tstep : cB;
        for (int t = 0; t < nt; t += 2) {
            const bool last = (t == nt - 2);
            const char* a1 = cA + (size_t)(t + 1) * kstep;
            const char* a2 = last ? nA : cA + (size_t)(t + 2) * kstep; const char* b2 = last ? nB : cB + (size_t)(t + 2) * kstep;
            const char* a3 = a2 + kstep; const char* b3 = b2 + kstep;
            if (last && has_next) S.a_ready(nxt);
            if constexpr (SP2) {
            PG8_LDB(B0, 0, 0); PG8_LDB(B1, 0, 1); PG8_SCHED; PG8_LDA(At, 0, 0); PG8_STAGE(PG8_SA(1, 1), a1 + hstep, voffA);
            PG8_WAIT_V(8); PG8_WAIT_L(0); PG8_BAR; PG8_MMA(0, 0, At, B0); PG8_MMA(0, 1, At, B1); PG8_BAR; PG8_SCHED;
            PG8_LDA(At, 0, 1); PG8_STAGE(PG8_SB(0, 0), b2, voffB); PG8_STAGE(PG8_SB(0, 1), b2 + hstep, voffB); PG8_STAGE(PG8_SA(0, 0), a2, voffA);
            PG8_WAIT_V(8); PG8_WAIT_L(0); PG8_BAR; PG8_MMA(1, 0, At, B0); PG8_MMA(1, 1, At, B1); PG8_BAR; PG8_SCHED;
            PG8_LDB(B0, 1, 0); PG8_LDB(B1, 1, 1); PG8_SCHED; PG8_LDA(At, 1, 0); PG8_STAGE(PG8_SA(0, 1), a2 + hstep, voffA);
            PG8_WAIT_V(8); PG8_WAIT_L(0); PG8_BAR; PG8_MMA(0, 0, At, B0); PG8_MMA(0, 1, At, B1); PG8_BAR; PG8_SCHED;
            PG8_LDA(At, 1, 1); PG8_STAGE(PG8_SB(1, 0), b3, voffB); PG8_STAGE(PG8_SB(1, 1), b3 + hstep, voffB); PG8_STAGE(PG8_SA(1, 0), a3, voffA);
            PG8_WAIT_V(8); PG8_WAIT_L(0); PG8_BAR; PG8_MMA(1, 0, At, B0); PG8_MMA(1, 1, At, B1); PG8_BAR; PG8_SCHED;
            } else {
            PG8_LDB(B0, 0, 0); PG8_SCHED; PG8_LDA(At, 0, 0); PG8_STAGE(PG8_SA(1, 1), a1 + hstep, voffA);
            PG8_WAIT_L(8); PG8_BAR; PG8_WAIT_L(0); PG8_MMA(0, 0, At, B0); PG8_BAR; PG8_SCHED;
            PG8_LDB(B1, 0, 1); PG8_STAGE(PG8_SB(0, 0), b2, voffB);
            PG8_BAR; PG8_WAIT_L(0); PG8_MMA(0, 1, At, B1); PG8_BAR;
            PG8_LDA(At, 0, 1); PG8_STAGE(PG8_SA(0, 0), a2, voffA);
            PG8_BAR; PG8_WAIT_L(0); PG8_MMA(1, 0, At, B0); PG8_BAR; PG8_SCHED;
            PG8_STAGE(PG8_SB(0, 1), b2 + hstep, voffB);
            PG8_WAIT_V(6); PG8_BAR; PG8_MMA(1, 1, At, B1); PG8_BAR;
            PG8_LDB(B0, 1, 0); PG8_SCHED; PG8_LDA(At, 1, 0); PG8_STAGE(PG8_SA(0, 1), a2 + hstep, voffA);
            PG8_WAIT_L(8); PG8_BAR; PG8_WAIT_L(0); PG8_MMA(0, 0, At, B0); PG8_BAR; PG8_SCHED;
            PG8_LDB(B1, 1, 1); PG8_STAGE(PG8_SB(1, 0), b3, voffB);
            PG8_BAR; PG8_WAIT_L(0); PG8_MMA(0, 1, At, B1); PG8_BAR;
            PG8_LDA(At, 1, 1); PG8_STAGE(PG8_SA(1, 0), a3, voffA);
            PG8_BAR; PG8_WAIT_L(0); PG8_MMA(1, 0, At, B0); PG8_BAR; PG8_SCHED;
            PG8_STAGE(PG8_SB(1, 1), b3 + hstep, voffB);
            PG8_WAIT_V(6); PG8_BAR; PG8_MMA(1, 1, At, B1); PG8_BAR;
            }
        }
        if constexpr (ALIGN_EPI) { if (wr == 0) PG8_BAR; }
        if constexpr (!Epi::AFTER_DRAIN) { E(acc, cur, wr, wc, fr, fq); S.done(cur); }
        if (!has_next) break;
#pragma unroll
        for (int a = 0; a < 2; ++a)
#pragma unroll
            for (int b = 0; b < 2; ++b)
#pragma unroll
                for (int m = 0; m < 4; ++m)
#pragma unroll
                    for (int n = 0; n < 2; ++n) acc[a][b][m][n] = (f32x4){0.f, 0.f, 0.f, 0.f};
        cur = nxt; cA = nA; cB = nB; ++ui;
        if constexpr (ALIGN_EPI) { if (wr == 1) PG8_BAR; }
    }
    PG8_WAIT_V(0);
    if constexpr (!ALIGN_EPI) { if (wr == 0) PG8_BAR; }
    PG8_BAR;
    if constexpr (Epi::AFTER_DRAIN) { E.fused(acc, cur, wr, wc, fr, fq, lds, wid, lane); S.done(cur); }
#undef PG8_SA
#undef PG8_SB
#undef PG8_STAGE
#undef PG8_LDA
#undef PG8_LDB
#undef PG8_MMA
#undef PG8_WAIT_V
#undef PG8_WAIT_L
#undef PG8_BAR
#undef PG8_SCHED
}
}
#define LAS __attribute__((address_space(3)))
typedef unsigned short bf16_t;
typedef float f32x4 __attribute__((ext_vector_type(4)));
typedef float f32x16 __attribute__((ext_vector_type(16)));
typedef short bf16x8 __attribute__((ext_vector_type(8)));
typedef short s16x4 __attribute__((ext_vector_type(4)));
typedef unsigned u32x4 __attribute__((ext_vector_type(4)));
typedef unsigned u32x2 __attribute__((ext_vector_type(2)));

constexpr int T_ = 16384, DM = 2048, DFF = 5632, SEQ = 2048, NBAT = 8, NH = 6, HD = 128, ZW = 5120, INW = 5126, PLE = 256;
constexpr int NPH_LAYER = 14, NPHASES = 28;
constexpr float LOG2E = 1.4426950408889634f, RMS_EPS = 1e-6f;
constexpr size_t MiB = (size_t)1 << 20;
#ifndef PADU
#define PADU 64
#endif
#ifndef PADA
#define PADA 64
#endif
#ifndef PADY
#define PADY 0
#endif
constexpr int LDU = DM + PADU, LDACT = DFF + PADA, LDY = DM + PADY;
constexpr size_t al1(size_t b) { return (b + MiB - 1) / MiB * MiB; }
constexpr size_t SZ_W1 = al1((size_t)2 * DFF * LDU * 2), SZ_W2 = al1((size_t)DM * LDACT * 2), SZ_WIN = al1((size_t)ZW * LDU * 2), SZ_WO = al1((size_t)DM * LDY * 2), SZ_WG = al1((size_t)DM * LDU * 2);
constexpr size_t WS_W1A = 0, WS_W2A = WS_W1A + SZ_W1, WS_WIN = WS_W2A + SZ_W2, WS_WO = WS_WIN + SZ_WIN, WS_W1B = WS_WO + SZ_WO, WS_W2B = WS_W1B + SZ_W1, WS_WG = WS_W2B + SZ_W2, WS_WP = WS_WG + SZ_WG,
                 WS_PW = WS_WP + MiB, WS_LOGF = WS_PW + MiB, WS_KSUM = WS_LOGF + MiB, WS_PBF = WS_KSUM + MiB, WS_U = WS_PBF + 8 * MiB, WS_Y = WS_U + al1((size_t)T_ * LDU * 2), WS_E = WS_Y + al1((size_t)T_ * LDY * 2),
                 WS_F = WS_E + 64 * MiB, WS_R = WS_F + 64 * MiB, WS_CTL = WS_R + al1((size_t)T_ * LDACT * 2), WS_END = WS_CTL + MiB;
static_assert((size_t)T_ * ZW * 2 <= (size_t)T_ * LDACT * 2, "z fits the act region");
constexpr size_t WS_R2 = WS_LOGF + 512 * 1024;
constexpr int XB_LDS_OFF = 147456 - 64;
constexpr int LDS_BYTES = 147456;

struct Args { const float* in[24]; float* out; unsigned char* ws; int ph_lo, ph_hi; };
typedef const __attribute__((address_space(4))) Args* ArgsP;

#define XB_TMO      128
#define XB_XCNT(j)  (256  + 64 * (j))
#define XB_XSUB(j)  (1280 + 64 * (j))
#define XB_XGEN(j)  (2304 + 64 * (j))
#define XB_TOP      3328
#define XB_TOPGEN   3392
#define XCD_BAR_WORDS 3456
#define XB_SPIN_CAP (1u << 18)

__device__ __forceinline__ unsigned xb_ld(unsigned* p)              { return __hip_atomic_load(p, __ATOMIC_RELAXED, __HIP_MEMORY_SCOPE_AGENT); }
__device__ __forceinline__ unsigned xb_add(unsigned* p, unsigned v) { return __hip_atomic_fetch_add(p, v, __ATOMIC_RELAXED, __HIP_MEMORY_SCOPE_AGENT); }
__device__ __forceinline__ unsigned xb_xcc_id() { return (unsigned)__builtin_amdgcn_s_getreg((3 << 11) | 20) & 0xFu; }
#define XB_SPIN(cond, bar) do { unsigned _sp = 0; while (cond) { __builtin_amdgcn_s_sleep(1); \
    if ((++_sp & 255u) == 0u) { if (xb_ld(&(bar)[XB_TMO])) break; if (_sp > XB_SPIN_CAP) { atomicAdd(&(bar)[XB_TMO], 1u); break; } } } } while (0)

struct XcdBarrier {
    unsigned* bar; unsigned x;
    volatile LAS unsigned* st;
};

__device__ __forceinline__ XcdBarrier xcd_barrier_post(unsigned* bar, volatile LAS unsigned* st) {
    XcdBarrier b; b.bar = bar; b.x = xb_xcc_id(); b.st = st;
    if (threadIdx.x == 0) (void)xb_add(&bar[XB_XCNT(b.x)], 1u);
    return b;
}
__device__ __forceinline__ void xcd_barrier_complete(unsigned* bar, unsigned x, unsigned& nloc, unsigned& nx) {
    const unsigned G = gridDim.x * gridDim.y * gridDim.z;
    unsigned sum, cnt, mine, sp = 0u;
    for (;;) {
        sum = 0u; cnt = 0u; mine = 0u;
#pragma unroll
        for (unsigned j = 0; j < 16; ++j) { const unsigned c = xb_ld(&bar[XB_XCNT(j)]); sum += c; cnt += (c > 0u) ? 1u : 0u; mine = (j == x) ? c : mine; }
        if (sum == G) break;
        __builtin_amdgcn_s_sleep(1);
        if ((++sp & 255u) == 0u) { if (xb_ld(&bar[XB_TMO])) break; if (sp > XB_SPIN_CAP) { atomicAdd(&bar[XB_TMO], 1u); break; } }
    }
    nloc = mine > 0u ? mine : 1u; nx = cnt > 0u ? cnt : 1u;
}

__device__ __forceinline__ void xcd_barrier(const XcdBarrier& b) {
    asm volatile("s_waitcnt vmcnt(0)" ::: "memory");
    __syncthreads();
    if (threadIdx.x == 0) {
        unsigned* bar = b.bar;
        __builtin_amdgcn_s_waitcnt(0);
        unsigned nloc = b.st[0], nx = b.st[1];
        if (nloc == 0u) { xcd_barrier_complete(bar, b.x, nloc, nx); b.st[0] = nloc; b.st[1] = nx; }
        const unsigned old = xb_add(&bar[XB_XSUB(b.x)], 1u);
        const unsigned gen = old / nloc;
        if (old + 1u == (gen + 1u) * nloc) {
            __builtin_amdgcn_fence(__ATOMIC_RELEASE, "agent");
            asm volatile("s_waitcnt vmcnt(0)" ::: "memory");
            const unsigned og = xb_add(&bar[XB_TOP], 1u);
            const unsigned tg = og / nx;
            if (og + 1u == (tg + 1u) * nx) xb_add(&bar[XB_TOPGEN], 1u);
            else XB_SPIN(xb_ld(&bar[XB_TOPGEN]) == tg, bar);
            __builtin_amdgcn_fence(__ATOMIC_ACQUIRE, "agent");
            xb_add(&bar[XB_XGEN(b.x)], 1u);
            asm volatile("s_waitcnt vmcnt(0)" ::: "memory");
        } else {
            XB_SPIN(xb_ld(&bar[XB_XGEN(b.x)]) == gen, bar);
            __builtin_amdgcn_fence(__ATOMIC_ACQUIRE, "agent");
            asm volatile("s_waitcnt vmcnt(0)" ::: "memory");
        }
    }
    __syncthreads();
}


__device__ __forceinline__ unsigned cvtpk(float lo, float hi) { unsigned r; asm volatile("v_cvt_pk_bf16_f32 %0, %1, %2" : "=v"(r) : "v"(lo), "v"(hi)); return r; }
__device__ __forceinline__ float wave_sum(float v) { return wave_sum_dpp(v); }
__device__ __forceinline__ float bfs2f(short s) { return __uint_as_float(((unsigned)(unsigned short)s) << 16); }
#define LDS_WAIT() asm volatile("s_waitcnt lgkmcnt(0)" ::: "memory")

__device__ __forceinline__ void conv_item(const float* W, const float* gk, int ldw, int ldt, int nsrc0, bf16_t* WT, int drow0, int kb, LAS float* scr, int lane) {
    const int k0 = 64 * kb;
    const float* wp = W + (size_t)k0 * ldw + nsrc0 + lane;
    float v[64];
#pragma unroll
    for (int i = 0; i < 64; ++i) v[i] = wp[(size_t)i * ldw];
    if (gk) {
#pragma unroll
        for (int i = 0; i < 64; ++i) v[i] *= gk[k0 + i];
    }
#pragma unroll
    for (int i = 0; i < 64; ++i) scr[i * 65 + lane] = v[i];
    LDS_WAIT(); asm volatile("" ::: "memory");
    const int c = lane & 7;
#pragma unroll
    for (int j = 0; j < 8; ++j) { const int n = (lane >> 3) + 8 * j; const LAS float* s = scr + (8 * c) * 65 + n;
        u32x4 o; o.x = cvtpk(s[0 * 65], s[1 * 65]); o.y = cvtpk(s[2 * 65], s[3 * 65]); o.z = cvtpk(s[4 * 65], s[5 * 65]); o.w = cvtpk(s[6 * 65], s[7 * 65]);
        *(u32x4*)(WT + (size_t)(drow0 + n) * ldt + k0 + 8 * c) = o; }
    LDS_WAIT(); asm volatile("" ::: "memory");
}
__device__ __forceinline__ bool conv_seg(int& it, const float* W, const float* gk, int K, int ldw, int nbeg, int ngrp, bf16_t* WT, int ldt, int mode, int row_off, LAS float* scr, int lane) {
    const int items = (K / 64) * ngrp;
    if (it >= items) { it -= items; return false; }
    const int kb = it / ngrp, nb = it % ngrp, nloc = 64 * nb;
    const int dst = (mode == 0) ? (row_off + nloc) : ((nloc >> 7) * 256 + (nloc & 127) + (mode == 2 ? 128 : 0));
    conv_item(W, gk, ldw, ldt, nbeg + nloc, WT, dst, kb, scr, lane);
    return true;
}
__device__ __forceinline__ void convert_layer(ArgsP a, LAS unsigned char* lds, int L) {
    const int tid = TIDX, lane = tid & 63, wave = __builtin_amdgcn_readfirstlane(tid >> 6);
    LAS float* scr = (LAS float*)(lds + wave * 16640);
    const int gw = blockIdx.x * 8 + wave, NGW = gridDim.x * 8;
    unsigned char* ws = a->ws;
    const size_t oFF = (size_t)L * DM * DFF, oDD = (size_t)L * DM * DM;
    constexpr int I_FF = (DM / 64) * (DFF / 64);
    constexpr int NITEMS = 6 * I_FF + 32 * 44 + 32 * 36 + 2 * (32 * 32) + 4 * 32 + 16;
    for (int it0 = gw; it0 < NITEMS; it0 += NGW) {
        int it = it0;
        if (conv_seg(it, a->in[5] + oFF, a->in[3] + (size_t)L * DM, DM, DFF, 0, DFF / 64, (bf16_t*)(ws + WS_W1A), LDU, 1, 0, scr, lane)) continue;
        if (conv_seg(it, a->in[6] + oFF, a->in[3] + (size_t)L * DM, DM, DFF, 0, DFF / 64, (bf16_t*)(ws + WS_W1A), LDU, 2, 0, scr, lane)) continue;
        if (conv_seg(it, a->in[7] + oFF, nullptr, DFF, DM, 0, DM / 64, (bf16_t*)(ws + WS_W2A), LDACT, 0, 0, scr, lane)) continue;
        if (conv_seg(it, a->in[10] + (size_t)L * DM * INW, a->in[8] + (size_t)L * DM, DM, INW, 0, 44, (bf16_t*)(ws + WS_WIN), LDU, 0, 0, scr, lane)) continue;
        if (conv_seg(it, a->in[10] + (size_t)L * DM * INW, a->in[8] + (size_t)L * DM, DM, INW, 2822, 36, (bf16_t*)(ws + WS_WIN), LDU, 0, 2816, scr, lane)) continue;
        if (conv_seg(it, a->in[14] + oDD, nullptr, DM, DM, 0, DM / 64, (bf16_t*)(ws + WS_WO), LDY, 0, 0, scr, lane)) continue;
        if (conv_seg(it, a->in[17] + oFF, a->in[15] + (size_t)L * DM, DM, DFF, 0, DFF / 64, (bf16_t*)(ws + WS_W1B), LDU, 1, 0, scr, lane)) continue;
        if (conv_seg(it, a->in[18] + oFF, a->in[15] + (size_t)L * DM, DM, DFF, 0, DFF / 64, (bf16_t*)(ws + WS_W1B), LDU, 2, 0, scr, lane)) continue;
        if (conv_seg(it, a->in[19] + oFF, nullptr, DFF, DM, 0, DM / 64, (bf16_t*)(ws + WS_W2B), LDACT, 0, 0, scr, lane)) continue;
        if (conv_seg(it, a->in[22] + oDD, a->in[20] + (size_t)L * DM, DM, DM, 0, DM / 64, (bf16_t*)(ws + WS_WG), LDU, 0, 0, scr, lane)) continue;
        if (conv_seg(it, a->in[23] + (size_t)L * PLE * DM, nullptr, PLE, DM, 0, DM / 64, (bf16_t*)(ws + WS_WP), PLE, 0, 0, scr, lane)) continue;
        { const int g = it >> 2; int r = it & 3; conv_seg(r, a->in[12] + (size_t)(L * 4 + g) * 16384, nullptr, 128, 128, 0, 2, (bf16_t*)(ws + WS_PW) + (size_t)g * 16384, 128, 0, 0, scr, lane); }
    }
    const f32x4* ps = (const f32x4*)(a->in[1] + (size_t)L * T_ * PLE);
    u32x2* pd = (u32x2*)(ws + WS_PBF);
    for (int i = blockIdx.x * 512 + tid; i < T_ * PLE / 4; i += gridDim.x * 512) { const f32x4 v = ps[i]; u32x2 o; o.x = cvtpk(v.x, v.y); o.y = cvtpk(v.z, v.w); pd[i] = o; }
}

__device__ __forceinline__ float log_sigmoidf_(float x) { return fminf(x, 0.f) - 0.6931471805599453f * __builtin_amdgcn_logf(1.0f + __builtin_amdgcn_exp2f(-1.4426950408889634f * fabsf(x))); }
__device__ __forceinline__ void rowwise(ArgsP a, LAS unsigned char* lds, const float* xin, const bf16_t* f, float alpha, const float* gpost, const float* gnext,
                                        bool forget, const float* w_in_L, const float* fbias, bool final) {
    const int tid = TIDX, lane = tid & 63, wave = __builtin_amdgcn_readfirstlane(tid >> 6);
    LAS float* wf = (LAS float*)lds;
    if (forget) {
        for (int k = tid; k < DM; k += 512) { const float* src = w_in_L + (size_t)k * INW + 2816;
#pragma unroll
            for (int j = 0; j < 6; ++j) wf[j * DM + k] = src[j]; }
        __syncthreads();
    }
    bf16_t* HB = (bf16_t*)(a->ws + WS_U);
    float* R2 = (float*)(a->ws + WS_R2);
    float* logf_out = (float*)(a->ws + WS_LOGF);
    const int gw = blockIdx.x * 8 + wave, NGW = gridDim.x * 8;
    if (xin) {
        f32x4 xn[8];
        { const f32x4* hp = (const f32x4*)(xin + (size_t)gw * DM) + lane;
#pragma unroll
          for (int j = 0; j < 8; ++j) xn[j] = hp[64 * j]; }
        for (int r = gw; r < T_; r += NGW) {
            f32x4 h[8];
#pragma unroll
            for (int j = 0; j < 8; ++j) h[j] = xn[j];
            if (r + NGW < T_) { const f32x4* hp = (const f32x4*)(xin + (size_t)(r + NGW) * DM) + lane;
#pragma unroll
                for (int j = 0; j < 8; ++j) xn[j] = hp[64 * j]; }
            float ss2 = 0.f;
#pragma unroll
            for (int j = 0; j < 8; ++j) ss2 += (h[j].x * h[j].x + h[j].y * h[j].y) + (h[j].z * h[j].z + h[j].w * h[j].w);
            ss2 = wave_sum(ss2);
            const float r2 = rsqrtf(ss2 * (1.f / DM) + RMS_EPS);
            if (lane == 0) R2[r] = r2;
            u32x2* hbp = (u32x2*)(HB + (size_t)r * LDU) + lane;
#pragma unroll
            for (int j = 0; j < 8; ++j) { u32x2 o; o.x = cvtpk(h[j].x * r2, h[j].y * r2); o.y = cvtpk(h[j].z * r2, h[j].w * r2); st8(hbp + 64 * j, o); }
        }
        return;
    }
    f32x4 gp[8], gn[8];
#pragma unroll
    for (int j = 0; j < 8; ++j) { gp[j] = ((const f32x4*)gpost)[64 * j + lane]; gn[j] = forget ? ((const f32x4*)gnext)[64 * j + lane] : (f32x4){0.f, 0.f, 0.f, 0.f}; }
    u32x2 hn[8], fn[8], hn2[8], fn2[8]; float rn = R2[gw], rn2 = 1.f;
    { const u32x2* hp = (const u32x2*)(HB + (size_t)gw * LDU) + lane; const u32x2* fp = (const u32x2*)(f + (size_t)gw * DM) + lane;
#pragma unroll
      for (int j = 0; j < 8; ++j) { hn[j] = hp[64 * j]; fn[j] = fp[64 * j]; } }
    if (gw + NGW < T_) { rn2 = R2[gw + NGW]; const u32x2* hp = (const u32x2*)(HB + (size_t)(gw + NGW) * LDU) + lane; const u32x2* fp = (const u32x2*)(f + (size_t)(gw + NGW) * DM) + lane;
#pragma unroll
      for (int j = 0; j < 8; ++j) { hn2[j] = hp[64 * j]; fn2[j] = fp[64 * j]; } }
    for (int r = gw; r < T_; r += NGW) {
        f32x4 h[8], fv[8];
        u32x2* hbp = (u32x2*)(HB + (size_t)r * LDU) + lane;
        const float ir = 1.0f / rn;
#pragma unroll
        for (int j = 0; j < 8; ++j) { h[j] = (f32x4){pg8::bf_lo(hn[j].x), pg8::bf_hi(hn[j].x), pg8::bf_lo(hn[j].y), pg8::bf_hi(hn[j].y)} * ir;
                                      fv[j] = (f32x4){pg8::bf_lo(fn[j].x), pg8::bf_hi(fn[j].x), pg8::bf_lo(fn[j].y), pg8::bf_hi(fn[j].y)}; }
        rn = rn2;
#pragma unroll
        for (int j = 0; j < 8; ++j) { hn[j] = hn2[j]; fn[j] = fn2[j]; }
        if (r + 2 * NGW < T_) { rn2 = R2[r + 2 * NGW]; const u32x2* hp = (const u32x2*)(HB + (size_t)(r + 2 * NGW) * LDU) + lane; const u32x2* fp = (const u32x2*)(f + (size_t)(r + 2 * NGW) * DM) + lane;
#pragma unroll
            for (int j = 0; j < 8; ++j) { hn2[j] = hp[64 * j]; fn2[j] = fp[64 * j]; } }
        {
            float ss = 0.f;
#pragma unroll
            for (int j = 0; j < 8; ++j) ss += (fv[j].x * fv[j].x + fv[j].y * fv[j].y) + (fv[j].z * fv[j].z + fv[j].w * fv[j].w);
            ss = wave_sum(ss);
            const float rs = alpha * rsqrtf(ss * (1.f / DM) + RMS_EPS);
#pragma unroll
            for (int j = 0; j < 8; ++j) h[j] += fv[j] * gp[j] * rs;
        }
        if (final) {
            f32x4* op = (f32x4*)(a->out + (size_t)r * DM) + lane;
#pragma unroll
            for (int j = 0; j < 8; ++j) st16(op + 64 * j, __builtin_bit_cast(u32x4, h[j]));
        } else {
            float ss2 = 0.f;
#pragma unroll
            for (int j = 0; j < 8; ++j) ss2 += (h[j].x * h[j].x + h[j].y * h[j].y) + (h[j].z * h[j].z + h[j].w * h[j].w);
            ss2 = wave_sum(ss2);
            const float r2 = rsqrtf(ss2 * (1.f / DM) + RMS_EPS);
            if (lane == 0) R2[r] = r2;
#pragma unroll
            for (int j = 0; j < 8; ++j) { h[j] = h[j] * r2; u32x2 o; o.x = cvtpk(h[j].x, h[j].y); o.y = cvtpk(h[j].z, h[j].w); st8(hbp + 64 * j, o); }
            if (forget) {
                float mine = 0.f;
#pragma unroll
                for (int j = 0; j < 8; ++j) h[j] = h[j] * gn[j];
#pragma unroll
                for (int jj = 0; jj < 6; ++jj) { float s = 0.f;
#pragma unroll
                    for (int j = 0; j < 8; ++j) { const f32x4 w = *(const LAS f32x4*)(wf + jj * DM + 256 * j + 4 * lane); s += (h[j].x * w.x + h[j].y * w.y) + (h[j].z * w.z + h[j].w * w.w); }
                    s = wave_sum(s); if (lane == jj) mine = s; }
                if (lane < 6) { const int b = r >> 11, t = r & 2047; logf_out[(size_t)(b * NH + lane) * SEQ + t] = log_sigmoidf_(mine + fbias[lane]); }
            }
        }
    }
}

namespace att {
constexpr int KSTR = 272, VSTR = 320;
constexpr int L_K = 0, L_V = 64 * KSTR, BUFB = 64 * KSTR + 64 * VSTR, L_C = 2 * BUFB, L_KM = L_C + 8192, L_LUT = L_KM + 4096, L_RED = L_LUT + 544;
typedef short v4i16_t __attribute__((ext_vector_type(4)));
__device__ __forceinline__ s16x4 vtr(const LAS unsigned char* p) { return __builtin_bit_cast(s16x4, __builtin_amdgcn_ds_read_tr16_b64_v4i16((LAS v4i16_t*)p)); }
__device__ __forceinline__ f32x16 mfma32(bf16x8 a, bf16x8 b, f32x16 c) { return __builtin_amdgcn_mfma_f32_32x32x16_bf16(a, b, c, 0, 0, 0); }
__device__ __forceinline__ f32x16 zero16() { f32x16 z;
#pragma unroll
    for (int i = 0; i < 16; ++i) z[i] = 0.f; return z; }

__device__ __forceinline__ void attn_item(LAS unsigned char* lds, const bf16_t* Z, bf16_t* Y, const float* logf, const float* ksum, const float* rel_bias,
                                          const int moba, const int b, const int h, const int qt) {
    const int tid = TIDX, lane = tid & 63, wave = __builtin_amdgcn_readfirstlane(tid >> 6), ql = lane & 31, hh = lane >> 5;
    const int qrow = 256 * qt + 32 * wave + ql;
    const size_t tok = (size_t)b * SEQ + qrow;
    const int qcol = (moba ? 2816 : 512) + h * HD, kcol = qcol + 768;
    bf16x8 qf[8];
    { const bf16_t* qp = Z + tok * ZW + qcol + 8 * hh;
#pragma unroll
      for (int kk = 0; kk < 8; ++kk) qf[kk] = *(const bf16x8*)(qp + 16 * kk); }
    LAS float* cbuf = (LAS float*)(lds + L_C);
    LAS float* kmb = (LAS float*)(lds + L_KM);
    LAS float* lut = (LAS float*)(lds + L_LUT);
    LAS float* red = (LAS float*)(lds + L_RED);
    __syncthreads();
    const int nk = 256 * (qt + 1);
    if (!moba) {
        f32x4 v = (f32x4){0.f, 0.f, 0.f, 0.f};
        if (4 * tid < nk) v = *(const f32x4*)(logf + (size_t)(b * NH + h) * SEQ + 4 * tid);
        v.y += v.x; v.z += v.y; v.w += v.z;
        const float tot = v.w; float inc = tot;
#pragma unroll
        for (int o = 1; o < 64; o <<= 1) { const float t = __shfl_up(inc, o); if (lane >= o) inc += t; }
        if (lane == 63) red[wave] = inc;
        __syncthreads();
        float base = inc - tot;
#pragma unroll
        for (int w = 0; w < 8; ++w) if (w < wave) base += red[w];
        v = (v + base) * LOG2E;
        if (4 * tid < nk) *(LAS f32x4*)(cbuf + 4 * tid) = v;
    } else {
        for (int idx = tid; idx < 1024; idx += 512) { const int j = idx >> 7, d = idx & 127; const float* p0 = ksum + (size_t)((b * 8 + j) * 2) * 768 + h * HD + d; kmb[idx] = (p0[0] + p0[768]) * (1.f / 256.f); }
        if (tid <= 128) { const int n = tid; int bk;
            if (n < 16) bk = n; else { const float nf = (float)n; bk = 16 + (int)(__builtin_amdgcn_logf(nf * 0.0625f) * (16.f / 3.f)); bk = bk < 31 ? bk : 31; }
            lut[n] = rel_bias[bk * NH + h] * LOG2E; }
    }
    __syncthreads();
    unsigned sel = 0u; float cq2 = 0.f;
    if (moba) {
        float g[7];
#pragma unroll
        for (int j = 0; j < 7; ++j) { g[j] = -INFINITY;
            if (j < qt) { float s = 0.f;
#pragma unroll
                for (int kk = 0; kk < 8; ++kk) { const LAS float* kp = kmb + j * 128 + 16 * kk + 8 * hh; const f32x4 k0 = *(const LAS f32x4*)kp, k1 = *(const LAS f32x4*)(kp + 4); const bf16x8 q = qf[kk];
                    s += bfs2f(q[0]) * k0.x + bfs2f(q[1]) * k0.y + bfs2f(q[2]) * k0.z + bfs2f(q[3]) * k0.w + bfs2f(q[4]) * k1.x + bfs2f(q[5]) * k1.y + bfs2f(q[6]) * k1.z + bfs2f(q[7]) * k1.w; }
                s += __shfl_xor(s, 32); g[j] = s; } }
#pragma unroll
        for (int j = 0; j < 7; ++j) { int cnt = 0;
#pragma unroll
            for (int i = 0; i < 7; ++i) if (i != j) cnt += ((g[i] > g[j]) || (g[i] == g[j] && i < j)) ? 1 : 0;
            if (j < qt && cnt < 3) sel |= 1u << j; }
    } else cq2 = cbuf[qrow];

    const float sc2 = 0.08838834764831845f * LOG2E;
    f32x16 o0 = zero16(), o1 = zero16(), o2 = zero16(), o3 = zero16();
    float mrun = -INFINITY, lsum = 0.f;
    const int ntiles = 4 * (qt + 1);
    const int qmin_w = 256 * qt + 32 * wave, qmax_w = qmin_w + 31;
    const int r0 = tid >> 4, ch0 = tid & 15;
    const bf16_t* kg = Z + ((size_t)b * SEQ + r0) * ZW + kcol + 8 * ch0;
    u32x4 pk0 = *(const u32x4*)kg, pk1 = *(const u32x4*)(kg + (size_t)32 * ZW), pv0 = *(const u32x4*)(kg + 768), pv1 = *(const u32x4*)(kg + (size_t)32 * ZW + 768);
    const int kwoff = r0 * KSTR + ch0 * 16, vwoff = L_V + r0 * VSTR + ch0 * 16;
    const int kroff = ql * KSTR + 16 * hh;
    const int vroff = L_V + (4 * hh + ((lane & 15) >> 2)) * VSTR + (16 * ((lane >> 4) & 1) + 4 * (lane & 3)) * 2;
    *(LAS u32x4*)(lds + kwoff) = pk0; *(LAS u32x4*)(lds + kwoff + 32 * KSTR) = pk1;
    *(LAS u32x4*)(lds + vwoff) = pv0; *(LAS u32x4*)(lds + vwoff + 32 * VSTR) = pv1;
    kg += (size_t)64 * ZW; pk0 = *(const u32x4*)kg; pk1 = *(const u32x4*)(kg + (size_t)32 * ZW); pv0 = *(const u32x4*)(kg + 768); pv1 = *(const u32x4*)(kg + (size_t)32 * ZW + 768);
    __syncthreads();
    for (int t = 0; t < ntiles; ++t) {
        const int cur = (t & 1) * BUFB, nxt = BUFB - cur;
        if (t + 1 < ntiles) {
            *(LAS u32x4*)(lds + nxt + kwoff) = pk0; *(LAS u32x4*)(lds + nxt + kwoff + 32 * KSTR) = pk1;
            *(LAS u32x4*)(lds + nxt + vwoff) = pv0; *(LAS u32x4*)(lds + nxt + vwoff + 32 * VSTR) = pv1;
            if (t + 2 < ntiles) { kg += (size_t)64 * ZW; pk0 = *(const u32x4*)kg; pk1 = *(const u32x4*)(kg + (size_t)32 * ZW); pv0 = *(const u32x4*)(kg + 768); pv1 = *(const u32x4*)(kg + (size_t)32 * ZW + 768); }
        }
        const LAS unsigned char* Kb = lds + cur; const LAS unsigned char* Vb = lds + cur;
        const int k0 = 64 * t;
        if (k0 <= qmax_w) {
            f32x16 s0 = zero16(), s1 = zero16();
#pragma unroll
            for (int kk = 0; kk < 8; ++kk) { const bf16x8 a0 = *(const LAS bf16x8*)(Kb + kroff + 32 * kk), a1 = *(const LAS bf16x8*)(Kb + kroff + 32 * KSTR + 32 * kk);
                s0 = mfma32(a0, qf[kk], s0); s1 = mfma32(a1, qf[kk], s1); }
            if (!moba) {
#pragma unroll
                for (int ig = 0; ig < 4; ++ig) { const f32x4 cb0 = *(const LAS f32x4*)(cbuf + k0 + 8 * ig + 4 * hh), cb1 = *(const LAS f32x4*)(cbuf + k0 + 32 + 8 * ig + 4 * hh);
#pragma unroll
                    for (int e = 0; e < 4; ++e) { s0[4 * ig + e] = __builtin_fmaf(s0[4 * ig + e], sc2, cq2 - cb0[e]); s1[4 * ig + e] = __builtin_fmaf(s1[4 * ig + e], sc2, cq2 - cb1[e]); } }
                if (k0 + 63 > qmin_w) {
#pragma unroll
                    for (int i = 0; i < 16; ++i) { const int key = k0 + (i & 3) + 8 * (i >> 2) + 4 * hh; if (key > qrow) s0[i] = -INFINITY; if (key + 32 > qrow) s1[i] = -INFINITY; }
                }
            } else {
                const bool past = k0 < 256 * qt;
                if (past && (k0 + 63 + 113 <= qmin_w)) {
                    const float bias = ((sel >> (k0 >> 8)) & 1u) ? lut[128] : -INFINITY;
#pragma unroll
                    for (int i = 0; i < 16; ++i) { s0[i] = __builtin_fmaf(s0[i], sc2, bias); s1[i] = __builtin_fmaf(s1[i], sc2, bias); }
                } else {
#pragma unroll
                    for (int i = 0; i < 16; ++i) { const int key = k0 + (i & 3) + 8 * (i >> 2) + 4 * hh; const int d0 = qrow - key, d1 = d0 - 32;
                        const int dd0 = d0 < 0 ? 0 : (d0 > 128 ? 128 : d0), dd1 = d1 < 0 ? 0 : (d1 > 128 ? 128 : d1);
                        float v0 = __builtin_fmaf(s0[i], sc2, lut[dd0]), v1 = __builtin_fmaf(s1[i], sc2, lut[dd1]);
                        s0[i] = d0 < 0 ? -INFINITY : v0; s1[i] = d1 < 0 ? -INFINITY : v1; }
                }
                if (past && !(k0 + 63 + 113 <= qmin_w) && !((sel >> (k0 >> 8)) & 1u)) {
#pragma unroll
                    for (int i = 0; i < 16; ++i) { s0[i] = -INFINITY; s1[i] = -INFINITY; }
                }
            }
            float tm = fmaxf(s0[0], s1[0]);
#pragma unroll
            for (int i = 1; i < 16; ++i) tm = fmaxf(tm, fmaxf(s0[i], s1[i]));
            tm = fmaxf(tm, __shfl_xor(tm, 32));
            const float mnew = fmaxf(mrun, tm);
            const float muse = (mnew == -INFINITY) ? 0.f : mnew;
            const float alpha = __builtin_amdgcn_exp2f(mrun - muse);
            mrun = mnew;
            float ps = 0.f;
#pragma unroll
            for (int i = 0; i < 16; ++i) { s0[i] = __builtin_amdgcn_exp2f(s0[i] - muse); s1[i] = __builtin_amdgcn_exp2f(s1[i] - muse); ps += s0[i] + s1[i]; }
            lsum = lsum * alpha + ps;
            o0 *= alpha; o1 *= alpha; o2 *= alpha; o3 *= alpha;
            bf16x8 pb[4];
            { u32x4 w;
              w.x = cvtpk(s0[0], s0[1]); w.y = cvtpk(s0[2], s0[3]); w.z = cvtpk(s0[4], s0[5]); w.w = cvtpk(s0[6], s0[7]); pb[0] = __builtin_bit_cast(bf16x8, w);
              w.x = cvtpk(s0[8], s0[9]); w.y = cvtpk(s0[10], s0[11]); w.z = cvtpk(s0[12], s0[13]); w.w = cvtpk(s0[14], s0[15]); pb[1] = __builtin_bit_cast(bf16x8, w);
              w.x = cvtpk(s1[0], s1[1]); w.y = cvtpk(s1[2], s1[3]); w.z = cvtpk(s1[4], s1[5]); w.w = cvtpk(s1[6], s1[7]); pb[2] = __builtin_bit_cast(bf16x8, w);
              w.x = cvtpk(s1[8], s1[9]); w.y = cvtpk(s1[10], s1[11]); w.z = cvtpk(s1[12], s1[13]); w.w = cvtpk(s1[14], s1[15]); pb[3] = __builtin_bit_cast(bf16x8, w); }
#pragma unroll
            for (int c = 0; c < 4; ++c) {
                const LAS unsigned char* vp = Vb + vroff + (16 * c) * VSTR;
#define ATT_PV(db, od) { const s16x4 lo = vtr(vp + 64 * (db)), hi = vtr(vp + 8 * VSTR + 64 * (db)); const bf16x8 A = __builtin_shufflevector(lo, hi, 0, 1, 2, 3, 4, 5, 6, 7); od = mfma32(A, pb[c], od); }
                ATT_PV(0, o0) ATT_PV(1, o1) ATT_PV(2, o2) ATT_PV(3, o3)
#undef ATT_PV
            }
        }
        __syncthreads();
    }
    lsum += __shfl_xor(lsum, 32);
    const float inv = 1.f / lsum;
    bf16_t* yp = Y + tok * LDY + (moba ? 1280 : 512) + h * HD + 4 * hh;
#define ATT_ST(db, od) { _Pragma("unroll") for (int ig = 0; ig < 4; ++ig) { u32x2 w; w.x = cvtpk(od[4 * ig] * inv, od[4 * ig + 1] * inv); w.y = cvtpk(od[4 * ig + 2] * inv, od[4 * ig + 3] * inv); st8(yp + 32 * (db) + 8 * ig, w); } }
    ATT_ST(0, o0) ATT_ST(1, o1) ATT_ST(2, o2) ATT_ST(3, o3)
#undef ATT_ST
}

__device__ __forceinline__ void pool_item(LAS unsigned char* lds, const bf16_t* Z, bf16_t* Y, const bf16_t* PW, const float* pscale, const int tile, const int g) {
    const int tid = TIDX, lane = tid & 63, wave = __builtin_amdgcn_readfirstlane(tid >> 6), ql = lane & 31, hh = lane >> 5;
    const int tok0 = tile * 256;
    constexpr int VST = 69632;
    __syncthreads();
    const bool first = (tok0 & 2047) == 0;
    {
        u32x4 sv[9];
#pragma unroll
        for (int i = 0; i < 9; ++i) { const int c = tid + 512 * i, row = c >> 4, ch = c & 15;
            sv[i] = (u32x4){0u, 0u, 0u, 0u};
            if (c < 271 * 16 && !(first && row < 15)) sv[i] = *(const u32x4*)(Z + (size_t)(tok0 - 15 + row) * ZW + g * 128 + 8 * ch); }
#pragma unroll
        for (int i = 0; i < 9; ++i) { const int c = tid + 512 * i, row = c >> 4, ch = c & 15;
            if (c < 271 * 16) *(LAS u32x4*)(lds + VST + row * 272 + 16 * ch) = sv[i]; }
    }
    __syncthreads();
    { const int cp = tid & 63, seg = tid >> 6;
#define POOL_ROWS(W) \
      for (int i = 0; i < 32; ++i) { const int row = 32 * seg + i, pos = (tok0 + row) & 2047; \
        const int cnt = (pos + 1 < (W)) ? pos + 1 : (W); \
        const LAS unsigned char* vp = lds + VST + (row + 15) * 272 + 4 * cp; \
        float s0 = 0.f, s1 = 0.f; \
        _Pragma("unroll") for (int sft = (W) - 1; sft >= 0; --sft) { const unsigned v = *(const LAS unsigned*)(vp - sft * 272); if (sft < cnt) { s0 += pg8::bf_lo(v); s1 += pg8::bf_hi(v); } } \
        const unsigned vc = *(const LAS unsigned*)vp; \
        const float fc = (float)cnt; \
        *(LAS unsigned*)(lds + row * 272 + 4 * cp) = cvtpk(s0 / fc - pg8::bf_lo(vc), s1 / fc - pg8::bf_hi(vc)); }
      if (g == 0) { POOL_ROWS(2) } else if (g == 1) { POOL_ROWS(4) } else if (g == 2) { POOL_ROWS(8) } else { POOL_ROWS(16) }
#undef POOL_ROWS
    }
    __syncthreads();
    bf16x8 bfr[8];
#pragma unroll
    for (int kk = 0; kk < 8; ++kk) bfr[kk] = *(const LAS bf16x8*)(lds + (32 * wave + ql) * 272 + 32 * kk + 16 * hh);
    const size_t tok = (size_t)tok0 + 32 * wave + ql;
#pragma unroll
    for (int nb = 0; nb < 4; ++nb) {
        f32x16 acc = zero16();
        const bf16_t* wp = PW + (size_t)g * 16384 + (32 * nb + ql) * 128 + 8 * hh;
#pragma unroll
        for (int kk = 0; kk < 8; ++kk) { const bf16x8 A = *(const bf16x8*)(wp + 16 * kk); acc = mfma32(A, bfr[kk], acc); }
#pragma unroll
        for (int ig = 0; ig < 4; ++ig) { const f32x4 sc = *(const f32x4*)(pscale + g * 128 + 32 * nb + 8 * ig + 4 * hh);
            u32x2 o; o.x = cvtpk(acc[4 * ig] * sc.x, acc[4 * ig + 1] * sc.y); o.y = cvtpk(acc[4 * ig + 2] * sc.z, acc[4 * ig + 3] * sc.w);
            st8(Y + tok * LDY + g * 128 + 32 * nb + 8 * ig + 4 * hh, o); }
    }
}
}

__device__ __forceinline__ void attn_phase(ArgsP a, LAS unsigned char* lds, int L) {
    const bf16_t* Z = (const bf16_t*)(a->ws + WS_R); bf16_t* Y = (bf16_t*)(a->ws + WS_Y);
    const float* logf = (const float*)(a->ws + WS_LOGF); const float* ksum = (const float*)(a->ws + WS_KSUM);
    const int blk = blockIdx.x, G = gridDim.x;
    const int nrounds = (G == 256) ? 3 : (768 + G - 1) / G;
    for (int r = 0; r < nrounds; ++r) {
        const int e = (G == 256) ? ((r == 0) ? blk : (r == 1 ? 511 - blk : 512 + (blk ^ 1))) : (blk + r * G);
        if (e >= 768) break;
        const int qt = 7 - e / 96, rest = e % 96, moba = rest & 1, bh = rest >> 1;
        att::attn_item(lds, Z, Y, logf, ksum, a->in[2], moba, bh / 6, bh % 6, qt);
    }
    for (int pi = blk; pi < 256; pi += G) att::pool_item(lds, Z, Y, (const bf16_t*)(a->ws + WS_PW), a->in[13] + (size_t)L * 512, pi >> 2, pi & 3);
}

#ifndef WGM_N2048
#define WGM_N2048 4
#endif
template <class Epi> __device__ __forceinline__ void run_gemm(LAS unsigned char* lds, const bf16_t* A, const bf16_t* Bt, int N, int K, int ld, const Epi& E) {
    pg8::Gemm g{A, Bt, T_, N, K, ld}; pg8::StaticOrder S; S.init(T_, N, (int)gridDim.x, (int)blockIdx.x, (N == DM) ? WGM_N2048 : 8);
    pg8::gemm_phase<Epi, pg8::StaticOrder, true, true>(lds, g, S, E);
}

__device__ __forceinline__ void run_phase(ArgsP a, LAS unsigned char* lds, const int ph) {
    const int L = ph / NPH_LAYER, k = ph % NPH_LAYER;
    unsigned char* ws = a->ws;
    bf16_t* U = (bf16_t*)(ws + WS_U); bf16_t* Y = (bf16_t*)(ws + WS_Y); bf16_t* R = (bf16_t*)(ws + WS_R); bf16_t* E = (bf16_t*)(ws + WS_E);
    bf16_t* F = (bf16_t*)(ws + WS_F);
    const size_t oG = (size_t)L * DM;
#ifndef PHSEL
#define PHSEL 0xFFFF
#endif
    if ((PHSEL & 1) && k == 0) {
        convert_layer(a, lds, L);
        if (L == 0) { __syncthreads(); rowwise(a, lds, a->in[0], nullptr, 0.f, nullptr, nullptr, false, nullptr, nullptr, false); }
    } else if ((PHSEL & 2) && (k == 1 || k == 8)) {
        pg8::EpiSwiGLU Ep{R, LDACT, (const float*)(ws + WS_R2)};
        run_gemm(lds, U, (const bf16_t*)(ws + (k == 1 ? WS_W1A : WS_W1B)), 2 * DFF, DM, LDU, Ep);
    } else if ((PHSEL & 4) && (k == 2 || k == 6 || k == 9 || k == 10)) {
        pg8::EpiBf16P<false> Ep{(k == 10) ? E : F, DM, nullptr, nullptr};
        const bf16_t* A = (k == 6) ? Y : ((k == 10) ? (const bf16_t*)(ws + WS_PBF) : R);
        const bf16_t* Bt = (const bf16_t*)(ws + (k == 2 ? WS_W2A : (k == 6 ? WS_WO : (k == 9 ? WS_W2B : WS_WP))));
        run_gemm(lds, A, Bt, DM, (k == 6) ? DM : ((k == 10) ? PLE : DFF), (k == 6) ? LDY : ((k == 10) ? PLE : LDACT), Ep);
    } else if ((PHSEL & 8) && k == 4) {
        pg8::EpiBf16P<true> Ep{R, ZW, (float*)(ws + WS_KSUM), (const float*)(ws + WS_R2)};
        run_gemm(lds, U, (const bf16_t*)(ws + WS_WIN), ZW, DM, LDU, Ep);
    } else if ((PHSEL & 16) && k == 5) {
        attn_phase(a, lds, L);
    } else if ((PHSEL & 32) && k == 12) {
        pg8::EpiBf16Mul Ep{F, DM, E, (const float*)(ws + WS_R2)};
        run_gemm(lds, U, (const bf16_t*)(ws + WS_WG), DM, DM, LDU, Ep);
    } else if ((PHSEL & 64) && k == 3) {
        rowwise(a, lds, nullptr, F, 0.5f, a->in[4] + oG, a->in[8] + oG, true, a->in[10] + (size_t)L * DM * INW, a->in[11] + L * NH, false);
    } else if ((PHSEL & 128) && k == 7) {
        rowwise(a, lds, nullptr, F, 1.0f, a->in[9] + oG, nullptr, false, nullptr, nullptr, false);
    } else if ((PHSEL & 256) && k == 11) {
        rowwise(a, lds, nullptr, F, 0.5f, a->in[16] + oG, nullptr, false, nullptr, nullptr, false);
    } else if (PHSEL & 512) {
        rowwise(a, lds, nullptr, F, 1.0f, a->in[21] + oG, nullptr, false, nullptr, nullptr, L == 1);
    }
}

__global__ void __launch_bounds__(512, 2) fwd_kernel(Args a) {
    extern __shared__ __attribute__((aligned(16))) unsigned char lds_raw[];
    LAS unsigned char* lds = (LAS unsigned char*)lds_raw;
    cg::grid_group grid = cg::this_grid();
    if (threadIdx.x < 2) ((volatile LAS unsigned*)(lds + XB_LDS_OFF))[threadIdx.x] = 0u;
    __syncthreads();
    (void)xcd_barrier_post((unsigned*)(a.ws + WS_CTL), (volatile LAS unsigned*)(lds + XB_LDS_OFF));
    for (int ph = a.ph_lo; ph < a.ph_hi; ++ph) {
        ArgsP ap = (ArgsP)__builtin_amdgcn_kernarg_segment_ptr();
        asm volatile("" : "+s"(ap));
        run_phase(ap, lds, ph);
        if (ph + 1 < a.ph_hi) { if (ph == a.ph_lo) grid.sync(); else { XcdBarrier bar; bar.bar = (unsigned*)(ap->ws + WS_CTL); bar.x = xb_xcc_id(); bar.st = (volatile LAS unsigned*)(lds + XB_LDS_OFF); xcd_barrier(bar); } }
    }
}

extern "C" void kernel_launch(void* const* d_in, const int* in_sizes, int n_in, void* d_out, int out_size, void* d_ws, size_t ws_size, hipStream_t stream) {
    static int grid = 0;
    if (grid == 0) {
        if (n_in != 24 || out_size != T_ * DM || ws_size < WS_END) { fprintf(stderr, "kernel_launch: unexpected shapes: n_in %d out %d ws %zu (need %zu)\n", n_in, out_size, ws_size, (size_t)WS_END); grid = -1; return; }
        int dev = 0, cus = 0, per_cu = 0;
        hipGetDevice(&dev); hipDeviceGetAttribute(&cus, hipDeviceAttributeMultiprocessorCount, dev);
        if (hipFuncSetAttribute((const void*)fwd_kernel, hipFuncAttributeMaxDynamicSharedMemorySize, LDS_BYTES) != hipSuccess) { fprintf(stderr, "kernel_launch: hipFuncSetAttribute failed\n"); }
        if (hipOccupancyMaxActiveBlocksPerMultiprocessor(&per_cu, (const void*)fwd_kernel, 512, LDS_BYTES) != hipSuccess || per_cu < 1) per_cu = 1;
        (void)hipGetLastError();
        grid = cus * per_cu;
        if (grid <= 0) grid = 256;
    }
    if (grid < 0) return;
    if (hipMemsetAsync((char*)d_ws + WS_CTL, 0, 16384, stream) != hipSuccess) { fprintf(stderr, "kernel_launch: memset failed\n"); return; }
    Args a{};
    for (int i = 0; i < 24; ++i) a.in[i] = (const float*)d_in[i];
    a.out = (float*)d_out; a.ws = (unsigned char*)d_ws;
#if N_LAUNCH_MODE == 1
    a.ph_lo = 0; a.ph_hi = NPHASES;
    void* args[] = {&a};
    hipError_t e = hipLaunchCooperativeKernel((const void*)fwd_kernel, dim3(grid), dim3(512), args, LDS_BYTES, stream);
    if (e != hipSuccess) fprintf(stderr, "cooperative launch failed: %s (grid %d)\n", hipGetErrorString(e), grid);
#else
    for (int ph = 0; ph < NPHASES; ++ph) {
        a.ph_lo = ph; a.ph_hi = ph + 1;
        void* args[] = {&a};
        hipError_t e = hipLaunchCooperativeKernel((const void*)fwd_kernel, dim3(grid), dim3(512), args, LDS_BYTES, stream);
        if (e != hipSuccess) { fprintf(stderr, "launch %d failed: %s (grid %d)\n", ph, hipGetErrorString(e), grid); break; }
    }
#endif
}
```
